# Optimizing an MI355X kernel written in HIP

```python
import jax, jax.numpy as jnp
from jax import lax
import numpy as np

D_MODEL = 1024
BATCH = 16
SEQ = 4096
DEPTH = 1

CTX_LEN = 256
GRID_W = 64
N_HEADS = 16
N_KV_HEADS = 4
HEAD_DIM = 64
Q_GROUP = N_HEADS // N_KV_HEADS
WINDOW = 128
BLOCK = 128
N_FOURIER_GROUPS = 4
FOURIER_GROUP_DIM = 128
FOURIER_WIDTH = N_FOURIER_GROUPS * FOURIER_GROUP_DIM
D_FF = 2816
ROPE_BASE = 10000.0
AXIS_ROT_DIM = HEAD_DIM // 2
N_MOD = 9
RMS_EPS = 1e-6
NEG_INF = -1e30

ATTN_Q_W = N_HEADS * HEAD_DIM
ATTN_KV_W = N_KV_HEADS * HEAD_DIM
Q_OFF = 0
K_OFF = Q_OFF + ATTN_Q_W
V_OFF = K_OFF + ATTN_KV_W
U_OFF = V_OFF + ATTN_KV_W
GA_OFF = U_OFF + FOURIER_WIDTH
GF_OFF = GA_OFF + D_MODEL
D_IN = GF_OFF + D_MODEL

kernel_name = "hybrid_dit_window_gqa_fnet_macaron"


def rms_norm(x, g):
    xf = x.astype(jnp.float32)
    y = xf * lax.rsqrt(jnp.mean(xf * xf, axis=-1, keepdims=True) + RMS_EPS)
    return (y * g.astype(jnp.float32)).astype(x.dtype)


def mod_vec(mod, idx):
    return mod[:, idx][:, None, :]


def adaln_norm(x, g, mod, base):
    h = rms_norm(x, g)
    return h * (1.0 + mod_vec(mod, base + 1)) + mod_vec(mod, base)


def swiglu(h, w_in, w_out):
    hu = h @ w_in
    a, u = hu[..., :D_FF], hu[..., D_FF:]
    return (jax.nn.silu(a) * u) @ w_out


def macaron_ffn(x, mod, base, g, w_in, w_out):
    h = adaln_norm(x, g, mod, base)
    return x + 0.5 * mod_vec(mod, base + 2) * swiglu(h, w_in, w_out)


def axial_rope_angles(n_tokens):
    rows = n_tokens // GRID_W
    row = jnp.repeat(jnp.arange(rows, dtype=jnp.float32), GRID_W)
    col = jnp.tile(jnp.arange(GRID_W, dtype=jnp.float32), rows)
    inv_freq = ROPE_BASE ** (-jnp.arange(0, AXIS_ROT_DIM, 2, dtype=jnp.float32) / AXIS_ROT_DIM)
    ang = jnp.concatenate([row[:, None] * inv_freq, col[:, None] * inv_freq], axis=-1)
    return jnp.cos(ang), jnp.sin(ang)


def apply_rope(x, cos, sin):
    xp = x.reshape(x.shape[:-1] + (HEAD_DIM // 2, 2))
    xe, xo = xp[..., 0], xp[..., 1]
    c = cos[None, :, None, :].astype(x.dtype)
    s = sin[None, :, None, :].astype(x.dtype)
    out = jnp.stack([xe * c - xo * s, xe * s + xo * c], axis=-1)
    return out.reshape(x.shape)


def split_projection(p):
    b, n = p.shape[:2]
    q = p[..., Q_OFF:K_OFF].reshape(b, n, N_HEADS, HEAD_DIM)
    k = p[..., K_OFF:V_OFF].reshape(b, n, N_KV_HEADS, HEAD_DIM)
    v = p[..., V_OFF:U_OFF].reshape(b, n, N_KV_HEADS, HEAD_DIM)
    u = p[..., U_OFF:GA_OFF]
    ga = p[..., GA_OFF:GF_OFF]
    gf = p[..., GF_OFF:D_IN]
    return q, k, v, u, ga, gf


def windowed_attention_with_context(q, k, v, k_ctx, v_ctx, sink):
    b, n = q.shape[:2]
    n_ctx = k_ctx.shape[1]
    nb = n // BLOCK
    scale = HEAD_DIM ** -0.5
    qb = (q * scale).reshape(b, nb, BLOCK, N_KV_HEADS, Q_GROUP, HEAD_DIM).transpose(1, 0, 2, 3, 4, 5)
    pad = ((0, 0), (BLOCK, BLOCK), (0, 0), (0, 0))
    k_pad = jnp.pad(k, pad)
    v_pad = jnp.pad(v, pad)
    sink_b = jnp.broadcast_to(sink.astype(jnp.float32).reshape(1, N_KV_HEADS, Q_GROUP, 1, 1),
                              (b, N_KV_HEADS, Q_GROUP, BLOCK, 1))

    def block(args):
        i, qi = args
        start = i * BLOCK
        kb = lax.dynamic_slice_in_dim(k_pad, start, 3 * BLOCK, axis=1)
        vb = lax.dynamic_slice_in_dim(v_pad, start, 3 * BLOCK, axis=1)
        qpos = start + jnp.arange(BLOCK)
        kpos = start - BLOCK + jnp.arange(3 * BLOCK)
        valid = (jnp.abs(qpos[:, None] - kpos[None, :]) <= WINDOW) & (kpos[None, :] >= 0) & (kpos[None, :] < n)
        s_loc = jnp.einsum('bqkgd,bskd->bkgqs', qi, kb).astype(jnp.float32)
        s_loc = jnp.where(valid, s_loc, NEG_INF)
        s_ctx = jnp.einsum('bqkgd,bskd->bkgqs', qi, k_ctx).astype(jnp.float32)
        logits = jnp.concatenate([s_loc, s_ctx, sink_b], axis=-1)
        p = jax.nn.softmax(logits, axis=-1).astype(v.dtype)
        o = (jnp.einsum('bkgqs,bskd->bqkgd', p[..., :3 * BLOCK], vb)
             + jnp.einsum('bkgqs,bskd->bqkgd', p[..., 3 * BLOCK:3 * BLOCK + n_ctx], v_ctx))
        return o.reshape(b, BLOCK, ATTN_Q_W)

    out = lax.map(block, (jnp.arange(nb), qb))
    return out.transpose(1, 0, 2, 3).reshape(b, n, ATTN_Q_W)


def context_attention(q, k, v, sink):
    b, L = q.shape[:2]
    qg = (q * HEAD_DIM ** -0.5).reshape(b, L, N_KV_HEADS, Q_GROUP, HEAD_DIM)
    s = jnp.einsum('bqkgd,bskd->bkgqs', qg, k).astype(jnp.float32)
    sink_b = jnp.broadcast_to(sink.astype(jnp.float32).reshape(1, N_KV_HEADS, Q_GROUP, 1, 1),
                              (b, N_KV_HEADS, Q_GROUP, L, 1))
    p = jax.nn.softmax(jnp.concatenate([s, sink_b], axis=-1), axis=-1).astype(v.dtype)
    o = jnp.einsum('bkgqs,bskd->bqkgd', p[..., :L], v)
    return o.reshape(b, L, ATTN_Q_W)


def fourier_mix(u):
    b, n = u.shape[:2]
    ug = u.astype(jnp.float32).reshape(b, n, N_FOURIER_GROUPS, FOURIER_GROUP_DIM)
    f = jnp.fft.fft2(ug, axes=(1, 3), norm="ortho")
    return jnp.real(f).astype(u.dtype).reshape(b, n, FOURIER_WIDTH)


def merge_branches(a, f, ga, gf, w_a, w_f, w_o):
    y = jax.nn.sigmoid(ga) * (a @ w_a) + jax.nn.sigmoid(gf) * (f @ w_f)
    return y @ w_o


def setup_inputs(seed: int = 0) -> dict:
    key = jax.random.key(seed)
    ks = jax.random.split(key, 24)
    f32 = jnp.float32

    def dense(k, shape, fan_in, gain=1.0):
        return jax.random.normal(k, shape, f32) * (gain * fan_in ** -0.5)

    def gain_vec(k, shape):
        return 1.0 + 0.05 * jax.random.normal(k, shape, f32)

    return {
        "x": jax.random.normal(ks[0], (BATCH, SEQ, D_MODEL), f32),
        "c": jax.random.normal(ks[1], (BATCH, D_MODEL), f32),
        "ctx": jax.random.normal(ks[2], (BATCH, CTX_LEN, D_MODEL), f32),
        "c_ctx": jax.random.normal(ks[3], (D_MODEL,), f32),
        "w_ada": dense(ks[4], (DEPTH, D_MODEL, N_MOD * D_MODEL), D_MODEL, 0.5),
        "b_ada": 0.02 * jax.random.normal(ks[5], (DEPTH, N_MOD * D_MODEL), f32),
        "g_ffn1": gain_vec(ks[6], (DEPTH, D_MODEL)),
        "w_ffn1_in": dense(ks[7], (DEPTH, D_MODEL, 2 * D_FF), D_MODEL),
        "w_ffn1_out": dense(ks[8], (DEPTH, D_FF, D_MODEL), D_FF),
        "g_mix": gain_vec(ks[9], (DEPTH, D_MODEL)),
        "w_in": dense(ks[10], (DEPTH, D_MODEL, D_IN), D_MODEL),
        "attn_sink": 0.5 * jax.random.normal(ks[11], (DEPTH, N_HEADS), f32),
        "w_attn_branch": dense(ks[12], (DEPTH, ATTN_Q_W, D_MODEL), ATTN_Q_W),
        "w_fourier_branch": dense(ks[13], (DEPTH, FOURIER_WIDTH, D_MODEL), FOURIER_WIDTH),
        "w_out": dense(ks[14], (DEPTH, D_MODEL, D_MODEL), D_MODEL),
        "g_ffn2": gain_vec(ks[15], (DEPTH, D_MODEL)),
        "w_ffn2_in": dense(ks[16], (DEPTH, D_MODEL, 2 * D_FF), D_MODEL),
        "w_ffn2_out": dense(ks[17], (DEPTH, D_FF, D_MODEL), D_FF),
        "g_final": gain_vec(ks[18], (D_MODEL,)),
    }


def reference(x, c, ctx, c_ctx, w_ada, b_ada, g_ffn1, w_ffn1_in, w_ffn1_out, g_mix, w_in,
              attn_sink, w_attn_branch, w_fourier_branch, w_out, g_ffn2, w_ffn2_in, w_ffn2_out,
              g_final):
    b, n = x.shape[:2]
    cos, sin = axial_rope_angles(n)
    cond_lat = jax.nn.silu(c)
    cond_ctx = jax.nn.silu(c_ctx)[None]

    for layer in range(DEPTH):
        last = layer == DEPTH - 1
        mod_lat = (cond_lat @ w_ada[layer] + b_ada[layer]).reshape(b, N_MOD, D_MODEL)
        mod_ctx = (cond_ctx @ w_ada[layer] + b_ada[layer]).reshape(1, N_MOD, D_MODEL)

        x = macaron_ffn(x, mod_lat, 0, g_ffn1[layer], w_ffn1_in[layer], w_ffn1_out[layer])
        ctx = macaron_ffn(ctx, mod_ctx, 0, g_ffn1[layer], w_ffn1_in[layer], w_ffn1_out[layer])

        h_lat = adaln_norm(x, g_mix[layer], mod_lat, 3)
        h_ctx = adaln_norm(ctx, g_mix[layer], mod_ctx, 3)
        w_in_l = w_in[layer]
        sink = attn_sink[layer]
        if last:
            kv_c = h_ctx @ w_in_l[:, K_OFF:U_OFF]
            k_c = kv_c[..., :ATTN_KV_W].reshape(b, -1, N_KV_HEADS, HEAD_DIM)
            v_c = kv_c[..., ATTN_KV_W:].reshape(b, -1, N_KV_HEADS, HEAD_DIM)
        else:
            q_c, k_c, v_c, u_c, ga_c, gf_c = split_projection(h_ctx @ w_in_l)
            a_c = context_attention(q_c, k_c, v_c, sink)
            f_c = fourier_mix(u_c)
            ctx_mixed = ctx + mod_vec(mod_ctx, 5) * merge_branches(
                a_c, f_c, ga_c, gf_c, w_attn_branch[layer], w_fourier_branch[layer], w_out[layer])

        q, k, v, u, ga, gf = split_projection(h_lat @ w_in_l)
        q = apply_rope(q, cos, sin)
        k = apply_rope(k, cos, sin)
        a = windowed_attention_with_context(q, k, v, k_c, v_c, sink)
        f = fourier_mix(u)
        x = x + mod_vec(mod_lat, 5) * merge_branches(
            a, f, ga, gf, w_attn_branch[layer], w_fourier_branch[layer], w_out[layer])

        x = macaron_ffn(x, mod_lat, 6, g_ffn2[layer], w_ffn2_in[layer], w_ffn2_out[layer])
        if not last:
            ctx = macaron_ffn(ctx_mixed, mod_ctx, 6, g_ffn2[layer], w_ffn2_in[layer], w_ffn2_out[layer])

    return rms_norm(x, g_final)
```

```cpp
#include <hip/hip_runtime.h>
#include <hip/hip_cooperative_groups.h>
#include <cstdio>
#include <cstdint>
namespace cg = cooperative_groups;

#ifndef N_LAUNCH_PER_PHASE
#define N_LAUNCH_PER_PHASE 0
#endif

#define LAS __attribute__((address_space(3)))
typedef unsigned short bf16_t;
typedef short bf16x8 __attribute__((ext_vector_type(8)));
typedef float f32x4 __attribute__((ext_vector_type(4)));
typedef float f32x2 __attribute__((ext_vector_type(2)));
typedef unsigned u32x4 __attribute__((ext_vector_type(4)));
typedef unsigned u32x2 __attribute__((ext_vector_type(2)));

constexpr int DM = 1024, NB = 16, SEQ = 4096, CTXL = 256, DFF = 2816, NMOD = 9;
constexpr int NLAT = NB * SEQ;
constexpr int NCTX = NB * CTXL;
constexpr int NTOK = NLAT + NCTX;
constexpr int MODW = NMOD * DM;
constexpr float LOG2E = 1.4426950408889634f;
constexpr float QSCALE = 0.125f * LOG2E;
constexpr float RMS_EPS = 1e-6f;

constexpr size_t WS_W1IN = 0;
constexpr size_t WS_W1OUT = WS_W1IN + (size_t)2 * DFF * DM * 2;
constexpr size_t WS_W2IN = WS_W1OUT + (size_t)DM * DFF * 2;
constexpr size_t WS_W2OUT = WS_W2IN + (size_t)2 * DFF * DM * 2;
constexpr size_t WS_WINM = WS_W2OUT + (size_t)DM * DFF * 2;
constexpr size_t WS_WINT = WS_WINM + (size_t)3328 * DM * 2;
constexpr size_t WS_WA = WS_WINT + (size_t)1280 * DM * 2;
constexpr size_t WS_WF = WS_WA + (size_t)DM * DM * 2;
constexpr size_t WS_WO = WS_WF + (size_t)DM * 512 * 2;
constexpr size_t WS_DFT = WS_WO + (size_t)DM * DM * 2;
constexpr size_t WS_MODP = WS_DFT + (size_t)1024 * 2048 * 2;
constexpr size_t WS_MOD = WS_MODP + (size_t)8 * 17 * MODW * 4;
constexpr size_t WS_ROPE = WS_MOD + (size_t)17 * MODW * 4;
constexpr size_t WS_H = WS_ROPE + 8192;
constexpr size_t WS_ACT = WS_H + (size_t)NTOK * DM * 2;
constexpr size_t WS_X = WS_ACT + (size_t)NTOK * DFF * 2;
constexpr size_t WS_F = WS_X + (size_t)NTOK * DM * 4;
constexpr size_t WS_BAR = WS_F + (size_t)NLAT * 512 * 2;
constexpr size_t WS_PART = WS_BAR + 16384;
constexpr size_t WS_END = WS_PART + (size_t)4 * NCTX * DM * 4;
constexpr size_t AO_Q = 0;
constexpr size_t AO_K = AO_Q + (size_t)NLAT * 1024 * 2;
constexpr size_t AO_VT = AO_K + (size_t)NLAT * 256 * 2;
constexpr size_t AO_PQT = AO_VT + (size_t)256 * NLAT * 2;
constexpr size_t AO_KC = AO_PQT + (size_t)512 * NB * 8192 * 2;
constexpr size_t AO_VTC = AO_KC + (size_t)NCTX * 256 * 2;
static_assert(AO_KC >= (size_t)NLAT * 1024 * 4, "the f32 merge stash may only overlay q, k, V^T, PQ^T");
static_assert(WS_END <= (size_t)1073741824, "workspace");
static_assert(AO_VTC + (size_t)256 * NCTX * 2 <= (size_t)NTOK * DFF * 2, "act alias");

constexpr int LDS_BYTES = 131072 + 16;

__device__ __forceinline__ unsigned cvt_pk_bf16(float lo, float hi) { unsigned r; asm volatile("v_cvt_pk_bf16_f32 %0, %1, %2" : "=v"(r) : "v"(lo), "v"(hi)); return r; }
__device__ __forceinline__ float bf_lo(unsigned w) { return __uint_as_float(w << 16); }
__device__ __forceinline__ float bf_hi(unsigned w) { return __uint_as_float(w & 0xffff0000u); }
__device__ __forceinline__ float fast_sigmoid(float v) { return __builtin_amdgcn_rcpf(1.0f + __builtin_amdgcn_exp2f(-v * LOG2E)); }
__device__ __forceinline__ float wave_sum(float v) {
#pragma unroll
    for (int o = 1; o < 64; o <<= 1) v += __shfl_xor(v, o);
    return v;
}
#define LDS_WAIT() asm volatile("s_waitcnt lgkmcnt(0)" ::: "memory")
__device__ __forceinline__ int lane_id_fresh() { int l = (int)__builtin_amdgcn_mbcnt_hi(~0u, __builtin_amdgcn_mbcnt_lo(~0u, 0u)); asm volatile("" : "+v"(l)); return l; }
#define TID_FRESH(wv) ((int)((wv) << 6) | lane_id_fresh())

namespace pg8 {
constexpr int BM = 256, BK = 64, HALF = 128, HTB = HALF * BK * 2, NXCD = 8, WGM = 8;
__host__ __device__ __forceinline__ int lds_byte(int r, int c) { const int st = (r >> 4) * 2 + (c >> 5), rr = r & 15, cc = c & 31, ob = rr * 64 + cc * 2; return st * 1024 + (ob ^ (((ob >> 9) & 1) << 5)); }
__host__ __device__ __forceinline__ void stage_rc(int b, int& R, int& C) { const int st = b / 1024, sb = b % 1024, swz = sb ^ (((sb >> 9) & 1) << 5); R = (st >> 1) * 16 + swz / 64; C = (st & 1) * 32 + (swz % 64) / 2; }
__host__ __device__ __forceinline__ int perm32(int rho) { const int n = rho >> 4, i = rho & 15; return 8 * (i >> 2) + 4 * n + (i & 3); }
struct Unit { int pm, pn; };
struct Gemm { const bf16_t* A; const bf16_t* Bt; int lda, ldb, K, nM, nN, a_mod; size_t b_bstride; size_t a_bstride; int c_off; };
struct StaticOrder {
    int nM, nN, nwg, G, c;
    __device__ __forceinline__ void init(int nM_, int nN_, int G_, int c_) { nM = nM_; nN = nN_; nwg = nM * nN; G = G_; c = c_; }
    __device__ __forceinline__ bool next(int i, Unit& u) const {
        const long L = (long)i * G + c; if (L >= nwg) return false;
        int wgid = (int)L; { const int q = nwg / NXCD, r = nwg % NXCD, xcd = wgid % NXCD, off = wgid / NXCD; wgid = (xcd < r ? xcd * (q + 1) : r * (q + 1) + (xcd - r) * q) + off; }
        const int nig = WGM * nN, gid = wgid / nig, fm = gid * WGM, gsz = (nM - fm) < WGM ? (nM - fm) : WGM;
        u.pm = fm + ((wgid % nig) % gsz); u.pn = (wgid % nig) / gsz; return true;
    }
};
__device__ __forceinline__ const char* unit_a(const Gemm& g, const Unit& u) { return (const char*)g.A + ((size_t)(u.pm % g.a_mod) * BM * (size_t)g.lda + (size_t)(u.pm / g.a_mod) * g.a_bstride) * 2; }
template <int BMODE> __device__ __forceinline__ const char* unit_b(const Gemm& g, const Unit& u) {
    if (BMODE == 2) return (const char*)g.Bt + (size_t)((u.pn >> 4) * 4096 + (u.pn & 15) * 64) * (size_t)g.ldb * 2;
    return (const char*)g.Bt + ((size_t)u.pn * BM * (size_t)g.ldb + (size_t)(u.pm / g.a_mod) * g.b_bstride) * 2; }

template <class Epi>
__device__ __forceinline__ void gemm_phase(LAS unsigned char* lds, const Gemm g, const Epi& E, const int wv) {
    const int tid = TID_FRESH(wv), wid = wv, lane = tid & 63, wr = wid >> 2, wc = wid & 3, fr = lane & 15, fq = lane >> 4;
    const int K = g.K, nt = K / BK;
    StaticOrder S; S.init(g.nM, g.nN, (int)gridDim.x, (int)((blockIdx.x + (unsigned)g.c_off) % gridDim.x));
    unsigned voffA[2], voffB[2];
#pragma unroll
    for (int i = 0; i < 2; ++i) { int R, C; stage_rc(tid * 16 + i * 8192, R, C);
        const int Rb = Epi::BMODE == 1 ? ((R & ~31) + perm32(R & 31)) : (Epi::BMODE == 2 ? (1024 * ((R >> 4) & 1) + 16 * (R >> 5) + (R & 15)) : R);
        voffA[i] = (unsigned)(R * g.lda + C) * 2u; voffB[i] = (unsigned)(Rb * g.ldb + C) * 2u; }
    const size_t kstep = (size_t)(BK * 2);
    const size_t hstepA = (size_t)HALF * g.lda * 2, hstepB = (size_t)(Epi::BMODE == 2 ? 2048 : HALF) * g.ldb * 2;
    const unsigned ldsw = (unsigned)wid * 1024u;
    const int aoff = lds_byte(wr * 64 + fr, fq * 8), boff = lds_byte(wc * 32 + fr, fq * 8);
#define PG8_SA(b, h) (((b) * 2 + (h)) * HTB)
#define PG8_SB(b, h) ((4 + (b) * 2 + (h)) * HTB)
#define PG8_STAGE(bufoff, gbase, voff) do { _Pragma("unroll") for (int _i = 0; _i < 2; ++_i) \
        __builtin_amdgcn_global_load_lds((const unsigned*)((const char*)(gbase) + (voff)[_i]), (LAS unsigned*)(lds + (bufoff) + ldsw + _i * 8192), 16, 0, 0); } while (0)
#define PG8_LDA(dst, b, h) do { _Pragma("unroll") for (int m = 0; m < 4; ++m) _Pragma("unroll") for (int k = 0; k < 2; ++k) dst[m][k] = *(const LAS bf16x8*)(lds + PG8_SA(b, h) + aoff + m * 2048 + k * 1024); } while (0)
#define PG8_LDB(dst, b, h) do { _Pragma("unroll") for (int n = 0; n < 2; ++n) _Pragma("unroll") for (int k = 0; k < 2; ++k) dst[n][k] = *(const LAS bf16x8*)(lds + PG8_SB(b, h) + boff + n * 2048 + k * 1024); } while (0)
#define PG8_MMA(ai, bj, At, Bt) do { __builtin_amdgcn_s_setprio(1); _Pragma("unroll") for (int m = 0; m < 4; ++m) _Pragma("unroll") for (int n = 0; n < 2; ++n) _Pragma("unroll") for (int k = 0; k < 2; ++k) \
        acc[ai][bj][m][n] = __builtin_amdgcn_mfma_f32_16x16x32_bf16(Bt[n][k], At[m][k], acc[ai][bj][m][n], 0, 0, 0); __builtin_amdgcn_s_setprio(0); } while (0)
#define PG8_WAIT_V(n) asm volatile("s_waitcnt vmcnt(" #n ")" ::: "memory")
#define PG8_WAIT_L(n) asm volatile("s_waitcnt lgkmcnt(" #n ")" ::: "memory")
#define PG8_BAR __builtin_amdgcn_s_barrier()
#define PG8_SCHED __builtin_amdgcn_sched_barrier(0)
    Unit cur, nxt; int ui = 0;
    if (!S.next(0, cur)) return;
    f32x4 acc[2][2][4][2];
#pragma unroll
    for (int a = 0; a < 2; ++a)
#pragma unroll
        for (int b = 0; b < 2; ++b)
#pragma unroll
            for (int m = 0; m < 4; ++m)
#pragma unroll
                for (int n = 0; n < 2; ++n) acc[a][b][m][n] = (f32x4){0.f, 0.f, 0.f, 0.f};
    bf16x8 At[4][2], B0[2][2], B1[2][2];
    const char* cA = unit_a(g, cur); const char* cB = unit_b<Epi::BMODE>(g, cur);
    PG8_STAGE(PG8_SB(0, 0), cB, voffB); PG8_STAGE(PG8_SA(0, 0), cA, voffA); PG8_STAGE(PG8_SB(0, 1), cB + hstepB, voffB); PG8_STAGE(PG8_SA(0, 1), cA + hstepA, voffA);
    if (wr == 1) PG8_BAR;
    PG8_WAIT_V(4); PG8_BAR;
    PG8_STAGE(PG8_SB(1, 0), cB + kstep, voffB); PG8_STAGE(PG8_SA(1, 0), cA + kstep, voffA); PG8_STAGE(PG8_SB(1, 1), cB + hstepB + kstep, voffB);
    PG8_WAIT_V(6); PG8_BAR;
    for (;;) {
        const bool has_next = S.next(ui + 1, nxt);
        const char* nA = has_next ? unit_a(g, nxt) : cA; const char* nB = has_next ? unit_b<Epi::BMODE>(g, nxt) : cB;
#pragma nounroll
        for (int t = 0; t < nt; t += 2) {
            const bool last = (t == nt - 2);
            const char* a1 = cA + (size_t)(t + 1) * kstep;
            const char* a2 = last ? nA : cA + (size_t)(t + 2) * kstep; const char* b2 = last ? nB : cB + (size_t)(t + 2) * kstep;
            const char* a3 = a2 + kstep; const char* b3 = b2 + kstep;
            PG8_LDB(B0, 0, 0); PG8_SCHED; PG8_LDA(At, 0, 0); PG8_STAGE(PG8_SA(1, 1), a1 + hstepA, voffA);
            PG8_WAIT_L(8); PG8_BAR; PG8_WAIT_L(0); PG8_MMA(0, 0, At, B0); PG8_BAR; PG8_SCHED;
            PG8_LDB(B1, 0, 1); PG8_STAGE(PG8_SB(0, 0), b2, voffB);
            PG8_BAR; PG8_WAIT_L(0); PG8_MMA(0, 1, At, B1); PG8_BAR;
            PG8_LDA(At, 0, 1); PG8_STAGE(PG8_SA(0, 0), a2, voffA);
            PG8_BAR; PG8_WAIT_L(0); PG8_MMA(1, 0, At, B0); PG8_BAR; PG8_SCHED;
            PG8_STAGE(PG8_SB(0, 1), b2 + hstepB, voffB);
            PG8_WAIT_V(6); PG8_BAR; PG8_MMA(1, 1, At, B1); PG8_BAR;
            PG8_LDB(B0, 1, 0); PG8_SCHED; PG8_LDA(At, 1, 0); PG8_STAGE(PG8_SA(0, 1), a2 + hstepA, voffA);
            PG8_WAIT_L(8); PG8_BAR; PG8_WAIT_L(0); PG8_MMA(0, 0, At, B0); PG8_BAR; PG8_SCHED;
            PG8_LDB(B1, 1, 1); PG8_STAGE(PG8_SB(1, 0), b3, voffB);
            PG8_BAR; PG8_WAIT_L(0); PG8_MMA(0, 1, At, B1); PG8_BAR;
            PG8_LDA(At, 1, 1); PG8_STAGE(PG8_SA(1, 0), a3, voffA);
            PG8_BAR; PG8_WAIT_L(0); PG8_MMA(1, 0, At, B0); PG8_BAR; PG8_SCHED;
            PG8_STAGE(PG8_SB(1, 1), b3 + hstepB, voffB);
            PG8_WAIT_V(6); PG8_BAR; PG8_MMA(1, 1, At, B1); PG8_BAR;
        }
        E(acc, cur, wr, wc, fr, fq);
        if (!has_next) break;
#pragma unroll
        for (int a = 0; a < 2; ++a)
#pragma unroll
            for (int b = 0; b < 2; ++b)
#pragma unroll
                for (int m = 0; m < 4; ++m)
#pragma unroll
                    for (int n = 0; n < 2; ++n) acc[a][b][m][n] = (f32x4){0.f, 0.f, 0.f, 0.f};
        cur = nxt; cA = nA; cB = nB; ++ui;
    }
    PG8_WAIT_V(0);
    if (wr == 0) PG8_BAR;
    PG8_BAR;
#undef PG8_SA
#undef PG8_SB
#undef PG8_STAGE
#undef PG8_LDA
#undef PG8_LDB
#undef PG8_MMA
#undef PG8_WAIT_V
#undef PG8_WAIT_L
#undef PG8_BAR
#undef PG8_SCHED
}
}
using pg8::Unit; using pg8::Gemm; using pg8::gemm_phase;
typedef f32x4 AccT[2][2][4][2];

struct EpiSwiglu {
    static constexpr int BMODE = 1;
    bf16_t* out;
    __device__ __forceinline__ void operator()(const AccT& acc, const Unit& u, int wr, int wc, int fr, int fq) const {
        const int row0 = u.pm * 256 + wr * 64 + fr, col0 = u.pn * 128 + wc * 32 + 8 * fq;
#pragma unroll
        for (int ai = 0; ai < 2; ++ai)
#pragma unroll
            for (int m = 0; m < 4; ++m) {
                float r[8];
#pragma unroll
                for (int n = 0; n < 2; ++n)
#pragma unroll
                    for (int j = 0; j < 4; ++j) { const float a = acc[ai][0][m][n][j], uu = acc[ai][1][m][n][j]; r[n * 4 + j] = a * fast_sigmoid(a) * uu; }
                u32x4 w; w.x = cvt_pk_bf16(r[0], r[1]); w.y = cvt_pk_bf16(r[2], r[3]); w.z = cvt_pk_bf16(r[4], r[5]); w.w = cvt_pk_bf16(r[6], r[7]);
                *(u32x4*)(out + (size_t)(row0 + ai * 128 + m * 16) * DFF + col0) = w;
            }
    }
};
struct EpiResid {
    static constexpr int BMODE = 0;
    const float* xin_lat; const float* xin_ctx; float* out; const float* mod; int gidx; float gs;
    __device__ __forceinline__ void operator()(const AccT& acc, const Unit& u, int wr, int wc, int fr, int fq) const {
        const int rowt = u.pm * 256; const bool isctx = rowt >= NLAT;
        const float* gate = mod + (size_t)(isctx ? 16 : (rowt >> 12)) * MODW + gidx * DM;
        const float* xin = isctx ? xin_ctx - (size_t)NLAT * DM : xin_lat;
        const int row0 = rowt + wr * 64 + fr, col0 = u.pn * 256 + wc * 32 + 4 * fq;
        f32x4 gv[2][2];
#pragma unroll
        for (int bj = 0; bj < 2; ++bj)
#pragma unroll
            for (int n = 0; n < 2; ++n) gv[bj][n] = *(const f32x4*)(gate + col0 + bj * 128 + n * 16) * gs;
#pragma unroll
        for (int ai = 0; ai < 2; ++ai) {
            f32x4 xv[4][2][2];
#pragma unroll
            for (int m = 0; m < 4; ++m) {
                const size_t off = (size_t)(row0 + ai * 128 + m * 16) * DM + col0;
#pragma unroll
                for (int bj = 0; bj < 2; ++bj)
#pragma unroll
                    for (int n = 0; n < 2; ++n) xv[m][bj][n] = *(const f32x4*)(xin + off + bj * 128 + n * 16);
            }
#pragma unroll
            for (int m = 0; m < 4; ++m) {
                const size_t off = (size_t)(row0 + ai * 128 + m * 16) * DM + col0;
#pragma unroll
                for (int bj = 0; bj < 2; ++bj)
#pragma unroll
                    for (int n = 0; n < 2; ++n) *(f32x4*)(out + off + bj * 128 + n * 16) = xv[m][bj][n] + gv[bj][n] * acc[ai][bj][m][n];
            }
            asm volatile("" ::: "memory");
        }
    }
};
struct EpiQKG {
    static constexpr int BMODE = 1;
    bf16_t* q; bf16_t* k; bf16_t* ga; bf16_t* gf; const float* rope;
    __device__ __forceinline__ void operator()(const AccT& acc, const Unit& u, int wr, int wc, int fr, int fq) const {
        const int row0 = u.pm * 256 + wr * 64 + fr, cl = wc * 32 + 8 * fq;
        if (u.pn <= 4) {
            const bool isq = u.pn < 4; const float sc = isq ? QSCALE : 1.0f;
            bf16_t* dst = isq ? q + u.pn * 256 : k; const int ldc = isq ? 1024 : 256;
#pragma unroll
            for (int ai = 0; ai < 2; ++ai) {
                f32x4 csv[4], snv[4];
#pragma unroll
                for (int m = 0; m < 4; ++m) { const int n = (row0 + ai * 128 + m * 16) & 4095, pos = (wc & 1) ? (n & 63) : (n >> 6);
                    csv[m] = *(const f32x4*)(rope + pos * 16 + 4 * fq); snv[m] = *(const f32x4*)(rope + 1024 + pos * 16 + 4 * fq); }
#pragma unroll
                for (int m = 0; m < 4; ++m) {
                    const int row = row0 + ai * 128 + m * 16;
                    const f32x4 cs = csv[m] * sc, sn = snv[m] * sc;
#pragma unroll
                    for (int bj = 0; bj < 2; ++bj) {
                        const f32x4 v0 = acc[ai][bj][m][0], v1 = acc[ai][bj][m][1];
                        u32x4 w;
                        w.x = cvt_pk_bf16(v0[0] * cs[0] - v0[1] * sn[0], v0[0] * sn[0] + v0[1] * cs[0]);
                        w.y = cvt_pk_bf16(v0[2] * cs[1] - v0[3] * sn[1], v0[2] * sn[1] + v0[3] * cs[1]);
                        w.z = cvt_pk_bf16(v1[0] * cs[2] - v1[1] * sn[2], v1[0] * sn[2] + v1[1] * cs[2]);
                        w.w = cvt_pk_bf16(v1[2] * cs[3] - v1[3] * sn[3], v1[2] * sn[3] + v1[3] * cs[3]);
                        *(u32x4*)(dst + (size_t)row * ldc + bj * 128 + cl) = w;
                    }
                }
            }
        } else {
            bf16_t* dst = (u.pn < 9) ? ga + (u.pn - 5) * 256 : gf + (u.pn - 9) * 256;
#pragma unroll
            for (int ai = 0; ai < 2; ++ai)
#pragma unroll
                for (int m = 0; m < 4; ++m) {
                    const int row = row0 + ai * 128 + m * 16;
#pragma unroll
                    for (int bj = 0; bj < 2; ++bj) {
                        const f32x4 v0 = acc[ai][bj][m][0], v1 = acc[ai][bj][m][1];
                        u32x4 w; w.x = cvt_pk_bf16(v0[0], v0[1]); w.y = cvt_pk_bf16(v0[2], v0[3]); w.z = cvt_pk_bf16(v1[0], v1[1]); w.w = cvt_pk_bf16(v1[2], v1[3]);
                        *(u32x4*)(dst + (size_t)row * 1024 + bj * 128 + cl) = w;
                    }
                }
        }
    }
};
template <bool ONLYV> struct EpiT {
    static constexpr int BMODE = 1;
    bf16_t* vt; int ldv; bf16_t* pqt;
    __device__ __forceinline__ void operator()(const AccT& acc, const Unit& u, int wr, int wc, int fr, int fq) const {
        const int frow0 = u.pm * 256 + wr * 64 + fr, t0 = u.pn * 256 + wc * 32 + 8 * fq;
#pragma unroll
        for (int ai = 0; ai < 2; ++ai)
#pragma unroll
            for (int m = 0; m < 4; ++m) {
                const int frow = frow0 + ai * 128 + m * 16;
                bf16_t* rowp;
                if (ONLYV || u.pm == 0) rowp = vt + (size_t)frow * ldv + t0;
                else { const int fidx = frow - 256, pq = fidx >> 9, col = fidx & 511, b = t0 >> 12, n = t0 & 4095; rowp = pqt + (size_t)col * 131072 + b * 8192 + pq * 4096 + n; }
#pragma unroll
                for (int bj = 0; bj < 2; ++bj) {
                    const f32x4 v0 = acc[ai][bj][m][0], v1 = acc[ai][bj][m][1];
                    u32x4 w; w.x = cvt_pk_bf16(v0[0], v0[1]); w.y = cvt_pk_bf16(v0[2], v0[3]); w.z = cvt_pk_bf16(v1[0], v1[1]); w.w = cvt_pk_bf16(v1[2], v1[3]);
                    *(u32x4*)(rowp + bj * 128) = w;
                }
            }
    }
};
struct EpiPlain {
    static constexpr int BMODE = 1;
    bf16_t* out; int ldc; float scale;
    __device__ __forceinline__ void operator()(const AccT& acc, const Unit& u, int wr, int wc, int fr, int fq) const {
        const int row0 = u.pm * 256 + wr * 64 + fr, col0 = u.pn * 256 + wc * 32 + 8 * fq;
#pragma unroll
        for (int ai = 0; ai < 2; ++ai)
#pragma unroll
            for (int m = 0; m < 4; ++m) {
                bf16_t* rowp = out + (size_t)(row0 + ai * 128 + m * 16) * ldc + col0;
#pragma unroll
                for (int bj = 0; bj < 2; ++bj) {
                    const f32x4 v0 = acc[ai][bj][m][0] * scale, v1 = acc[ai][bj][m][1] * scale;
                    u32x4 w; w.x = cvt_pk_bf16(v0[0], v0[1]); w.y = cvt_pk_bf16(v0[2], v0[3]); w.z = cvt_pk_bf16(v1[0], v1[1]); w.w = cvt_pk_bf16(v1[2], v1[3]);
                    *(u32x4*)(rowp + bj * 128) = w;
                }
            }
    }
};
template <int PASS> struct EpiMerge {
    static constexpr int BMODE = 1;
    float* stash; bf16_t* gate;
    __device__ __forceinline__ void operator()(const AccT& acc, const Unit& u, int wr, int wc, int fr, int fq) const {
        const int row0 = u.pm * 256 + wr * 64 + fr, col0 = u.pn * 256 + wc * 32 + 8 * fq;
#pragma unroll
        for (int ai = 0; ai < 2; ++ai)
#pragma unroll
            for (int mh = 0; mh < 2; ++mh) {
                u32x4 gw[2][2]; f32x4 st0[2][2], st1[2][2];
#pragma unroll
                for (int mm = 0; mm < 2; ++mm)
#pragma unroll
                    for (int bj = 0; bj < 2; ++bj) {
                        const size_t off = (size_t)(row0 + ai * 128 + (mh * 2 + mm) * 16) * DM + col0 + bj * 128;
                        gw[mm][bj] = *(const u32x4*)(gate + off);
                        if (PASS == 2) { st0[mm][bj] = *(const f32x4*)(stash + off); st1[mm][bj] = *(const f32x4*)(stash + off + 4); }
                    }
#pragma unroll
                for (int mm = 0; mm < 2; ++mm)
#pragma unroll
                    for (int bj = 0; bj < 2; ++bj) {
                        const int m = mh * 2 + mm;
                        const size_t off = (size_t)(row0 + ai * 128 + m * 16) * DM + col0 + bj * 128;
                        const u32x4 g4 = gw[mm][bj];
                        const f32x4 v0 = acc[ai][bj][m][0], v1 = acc[ai][bj][m][1];
                        f32x4 r0, r1;
                        r0[0] = fast_sigmoid(bf_lo(g4.x)) * v0[0]; r0[1] = fast_sigmoid(bf_hi(g4.x)) * v0[1]; r0[2] = fast_sigmoid(bf_lo(g4.y)) * v0[2]; r0[3] = fast_sigmoid(bf_hi(g4.y)) * v0[3];
                        r1[0] = fast_sigmoid(bf_lo(g4.z)) * v1[0]; r1[1] = fast_sigmoid(bf_hi(g4.z)) * v1[1]; r1[2] = fast_sigmoid(bf_lo(g4.w)) * v1[2]; r1[3] = fast_sigmoid(bf_hi(g4.w)) * v1[3];
                        if (PASS == 1) { *(f32x4*)(stash + off) = r0; *(f32x4*)(stash + off + 4) = r1; }
                        else {
                            r0 += st0[mm][bj]; r1 += st1[mm][bj];
                            u32x4 w; w.x = cvt_pk_bf16(r0[0], r0[1]); w.y = cvt_pk_bf16(r0[2], r0[3]); w.z = cvt_pk_bf16(r1[0], r1[1]); w.w = cvt_pk_bf16(r1[2], r1[3]);
                            *(u32x4*)(gate + off) = w;
                        }
                    }
                asm volatile("" ::: "memory");
            }
    }
};
struct EpiFFT1 {
    static constexpr int BMODE = 2;
    bf16_t* yt;
    __device__ __forceinline__ void operator()(const AccT& acc, const Unit& u, int wr, int wc, int fr, int fq) const {
        const int b = u.pn >> 4, n2 = (u.pn & 15) * 64 + 16 * wc + 4 * fq;
        float tc[3][4], ts[3][4];
#pragma unroll
        for (int k1 = 1; k1 < 4; ++k1)
#pragma unroll
            for (int j = 0; j < 4; ++j) { const float x = (float)(k1 * (n2 + j)) * (1.0f / 4096.0f); tc[k1 - 1][j] = __builtin_amdgcn_cosf(x); ts[k1 - 1][j] = __builtin_amdgcn_sinf(x); }
#pragma unroll
        for (int m = 0; m < 4; ++m) {
            const int col = u.pm * 128 + wr * 64 + m * 16 + fr;
            bf16_t* base = yt + ((size_t)(b * 4) * 512 + col) * 2048 + n2;
            float yr[4][4], yi[4][4];
#pragma unroll
            for (int j = 0; j < 4; ++j) {
                const float z0r = acc[0][0][m][0][j], z1r = acc[0][0][m][1][j], z2r = acc[0][1][m][0][j], z3r = acc[0][1][m][1][j];
                const float z0i = -acc[1][0][m][0][j], z1i = -acc[1][0][m][1][j], z2i = -acc[1][1][m][0][j], z3i = -acc[1][1][m][1][j];
                const float ar = z0r + z2r, ai_ = z0i + z2i, br = z1r + z3r, bi = z1i + z3i, cr = z0r - z2r, ci = z0i - z2i, dr = z1r - z3r, di = z1i - z3i;
                yr[0][j] = ar + br; yi[0][j] = ai_ + bi;
                yr[2][j] = ar - br; yi[2][j] = ai_ - bi;
                yr[1][j] = cr + di; yi[1][j] = ci - dr;
                yr[3][j] = cr - di; yi[3][j] = ci + dr;
            }
#pragma unroll
            for (int k1 = 0; k1 < 4; ++k1) {
                float orr[4], oi[4];
#pragma unroll
                for (int j = 0; j < 4; ++j) {
                    if (k1 == 0) { orr[j] = yr[0][j]; oi[j] = yi[0][j]; }
                    else { const float c = tc[k1 - 1][j], s_ = ts[k1 - 1][j]; orr[j] = c * yr[k1][j] + s_ * yi[k1][j]; oi[j] = c * yi[k1][j] - s_ * yr[k1][j]; }
                }
                u32x2 w; w.x = cvt_pk_bf16(orr[0], orr[1]); w.y = cvt_pk_bf16(orr[2], orr[3]);
                *(u32x2*)(base + (size_t)k1 * 512 * 2048) = w;
                w.x = cvt_pk_bf16(oi[0], oi[1]); w.y = cvt_pk_bf16(oi[2], oi[3]);
                *(u32x2*)(base + (size_t)k1 * 512 * 2048 + 1024) = w;
            }
        }
    }
};
struct EpiFFT2 {
    static constexpr int BMODE = 1;
    bf16_t* out;
    __device__ __forceinline__ void operator()(const AccT& acc, const Unit& u, int wr, int wc, int fr, int fq) const {
        const float scale = 0.001381067932004975f;
        const int b = u.pm >> 4, k1 = (u.pm >> 2) & 3, k2b = (u.pm & 3) * 256 + wr * 64 + fr, col0 = u.pn * 256 + wc * 32 + 8 * fq;
#pragma unroll
        for (int ai = 0; ai < 2; ++ai)
#pragma unroll
            for (int m = 0; m < 4; ++m) {
                const int k2 = k2b + ai * 128 + m * 16;
                bf16_t* rowp = out + (size_t)(b * 4096 + k1 + 4 * k2) * 512 + col0;
#pragma unroll
                for (int bj = 0; bj < 2; ++bj) {
                    const f32x4 v0 = acc[ai][bj][m][0] * scale, v1 = acc[ai][bj][m][1] * scale;
                    u32x4 w; w.x = cvt_pk_bf16(v0[0], v0[1]); w.y = cvt_pk_bf16(v0[2], v0[3]); w.z = cvt_pk_bf16(v1[0], v1[1]); w.w = cvt_pk_bf16(v1[2], v1[3]);
                    *(u32x4*)(rowp + bj * 128) = w;
                }
            }
    }
};

struct EpiPartial {
    static constexpr int BMODE = 1;
    float* out;
    __device__ __forceinline__ void operator()(const AccT& acc, const Unit& u, int wr, int wc, int fr, int fq) const {
        const int row0 = u.pm * 256 + wr * 64 + fr, col0 = u.pn * 256 + wc * 32 + 8 * fq;
#pragma unroll
        for (int ai = 0; ai < 2; ++ai)
#pragma unroll
            for (int m = 0; m < 4; ++m) {
                float* rowp = out + (size_t)(row0 + ai * 128 + m * 16) * DM + col0;
#pragma unroll
                for (int bj = 0; bj < 2; ++bj) { *(f32x4*)(rowp + bj * 128) = acc[ai][bj][m][0]; *(f32x4*)(rowp + bj * 128 + 4) = acc[ai][bj][m][1]; }
                asm volatile("" ::: "memory");
            }
    }
};
struct Args { const float* in[19]; float* out; unsigned char* ws; int ph_lo, ph_hi; };

__device__ __forceinline__ void transpose_item(const float* W, int ldw, int k0, int n0, bf16_t* dst, int ldd, LAS float* scr, int lane) {
#pragma unroll 8
    for (int i = 0; i < 32; ++i) { const int kk = 2 * i + (lane >> 5); scr[kk * 33 + (lane & 31)] = W[(size_t)(k0 + kk) * ldw + n0 + (lane & 31)]; }
    LDS_WAIT(); asm volatile("" ::: "memory");
    const int c = lane & 7;
#pragma unroll
    for (int j = 0; j < 4; ++j) { const int n = (lane >> 3) + 8 * j; const LAS float* s = scr + (8 * c) * 33 + n;
        u32x4 o; o.x = cvt_pk_bf16(s[0 * 33], s[1 * 33]); o.y = cvt_pk_bf16(s[2 * 33], s[3 * 33]); o.z = cvt_pk_bf16(s[4 * 33], s[5 * 33]); o.w = cvt_pk_bf16(s[6 * 33], s[7 * 33]);
        *(u32x4*)(dst + (size_t)n * ldd + k0 + 8 * c) = o; }
    LDS_WAIT(); asm volatile("" ::: "memory");
}
__device__ __forceinline__ void fold_item(const float* w_in, bf16_t* wint, int item, LAS float* scr, const LAS float* tab, int lane) {
    const int g = item & 3, d0 = (item >> 2) * 8;
#pragma unroll
    for (int i = 0; i < 8; ++i) { const float* src = w_in + (size_t)(d0 + i) * 4096 + 1536 + g * 128; scr[lane * 8 + i] = src[lane]; scr[(lane + 64) * 8 + i] = src[lane + 64]; }
    LDS_WAIT(); asm volatile("" ::: "memory");
    float p0[8], p1[8], q0[8], q1[8];
#pragma unroll
    for (int i = 0; i < 8; ++i) { p0[i] = 0.f; p1[i] = 0.f; q0[i] = 0.f; q1[i] = 0.f; }
    for (int c = 0; c < 128; ++c) {
        const int idx = (lane * c) & 127; const float cv = tab[idx], sv = tab[128 + idx]; const float sg = (c & 1) ? -1.f : 1.f;
        const f32x4 wa = *(const LAS f32x4*)(scr + c * 8), wb = *(const LAS f32x4*)(scr + c * 8 + 4);
        const float w[8] = {wa[0], wa[1], wa[2], wa[3], wb[0], wb[1], wb[2], wb[3]};
#pragma unroll
        for (int i = 0; i < 8; ++i) { p0[i] += w[i] * cv; q0[i] += w[i] * sv; p1[i] += w[i] * (cv * sg); q1[i] += w[i] * (sv * sg); }
    }
    u32x4 o;
    o.x = cvt_pk_bf16(p0[0], p0[1]); o.y = cvt_pk_bf16(p0[2], p0[3]); o.z = cvt_pk_bf16(p0[4], p0[5]); o.w = cvt_pk_bf16(p0[6], p0[7]);
    *(u32x4*)(wint + (size_t)(256 + g * 256 + lane) * DM + d0) = o;
    o.x = cvt_pk_bf16(p1[0], p1[1]); o.y = cvt_pk_bf16(p1[2], p1[3]); o.z = cvt_pk_bf16(p1[4], p1[5]); o.w = cvt_pk_bf16(p1[6], p1[7]);
    *(u32x4*)(wint + (size_t)(256 + g * 256 + lane + 64) * DM + d0) = o;
    o.x = cvt_pk_bf16(q0[0], q0[1]); o.y = cvt_pk_bf16(q0[2], q0[3]); o.z = cvt_pk_bf16(q0[4], q0[5]); o.w = cvt_pk_bf16(q0[6], q0[7]);
    *(u32x4*)(wint + (size_t)(384 + g * 256 + lane) * DM + d0) = o;
    o.x = cvt_pk_bf16(q1[0], q1[1]); o.y = cvt_pk_bf16(q1[2], q1[3]); o.z = cvt_pk_bf16(q1[4], q1[5]); o.w = cvt_pk_bf16(q1[6], q1[7]);
    *(u32x4*)(wint + (size_t)(384 + g * 256 + lane + 64) * DM + d0) = o;
    LDS_WAIT(); asm volatile("" ::: "memory");
}

__device__ __forceinline__ void phase_prep(const Args& a, LAS unsigned char* lds, const int wv) {
    unsigned char* ws = a.ws;
    const int tid = TID_FRESH(wv), lane = tid & 63, wave = wv;
    const int G = gridDim.x;
    {
        LAS float* condS = (LAS float*)(lds + 69632) + (tid >> 8) * (17 * 128);
        const int half = tid >> 8, t = tid & 255;
        const float* cvec = a.in[1]; const float* cctx = a.in[3]; const float* wada = a.in[4];
        float* modp = (float*)(ws + WS_MODP);
        for (int base = blockIdx.x * 2; base < 288; base += 2 * G) {
            const int it = base + half, s = it / 36, cb = it % 36;
            for (int i = t; i < 17 * 128; i += 256) { const int r = i >> 7, kk = i & 127; const float v = (r < 16) ? cvec[r * DM + s * 128 + kk] : cctx[s * 128 + kk]; condS[i] = v / (1.0f + __expf(-v)); }
            __syncthreads();
            float acc[17];
#pragma unroll
            for (int r = 0; r < 17; ++r) acc[r] = 0.f;
            const int col = cb * 256 + t;
            for (int kk = 0; kk < 128; ++kk) {
                const float w = wada[(size_t)(s * 128 + kk) * MODW + col];
#pragma unroll
                for (int r = 0; r < 17; ++r) acc[r] += condS[r * 128 + kk] * w;
            }
#pragma unroll
            for (int r = 0; r < 17; ++r) modp[(size_t)(s * 17 + r) * MODW + col] = acc[r];
            __syncthreads();
        }
    }
    LAS float* tab = (LAS float*)(lds + 69632 + 17408);
    if (tid < 128) { tab[tid] = cospif((float)tid * (1.0f / 64.0f)); tab[128 + tid] = sinpif((float)tid * (1.0f / 64.0f)); }
    __syncthreads();
    {
        float* rope = (float*)(ws + WS_ROPE);
        const int gt = blockIdx.x * 512 + tid;
        if (gt < 1024) { const int pos = gt >> 4, i = gt & 15; const float inv = powf(10000.0f, -(float)i * (1.0f / 16.0f)); const float ang = (float)pos * inv; rope[gt] = cosf(ang); rope[1024 + gt] = sinf(ang); }
    }
    {
        LAS float* scr = (LAS float*)(lds + wave * 8448);
        const int gw = blockIdx.x * 8 + wave, NGW = G * 8;
        bf16_t* w1in = (bf16_t*)(ws + WS_W1IN); bf16_t* w1out = (bf16_t*)(ws + WS_W1OUT); bf16_t* w2in = (bf16_t*)(ws + WS_W2IN); bf16_t* w2out = (bf16_t*)(ws + WS_W2OUT);
        bf16_t* winm = (bf16_t*)(ws + WS_WINM); bf16_t* wint = (bf16_t*)(ws + WS_WINT); bf16_t* wa = (bf16_t*)(ws + WS_WA); bf16_t* wf = (bf16_t*)(ws + WS_WF); bf16_t* wo = (bf16_t*)(ws + WS_WO);
#define TJOB(SRC, LDW, KK, NBEG, NCNT, DST, LDD, SWI) { const int nb_ = (NCNT) / 32, cnt_ = ((KK) / 64) * nb_; if (r < cnt_) { const int kb = r / nb_, nb = r % nb_; const int n0 = 32 * nb; int drow = n0; \
            if (SWI) { drow = (n0 < DFF) ? (256 * (n0 / 128) + (n0 % 128)) : (256 * ((n0 - DFF) / 128) + 128 + ((n0 - DFF) % 128)); } \
            transpose_item(SRC, LDW, 64 * kb, (NBEG) + n0, (DST) + (size_t)drow * (LDD), LDD, scr, lane); continue; } r -= cnt_; }
        constexpr int NIT = 2 * (16 * 176 + 44 * 32) + 16 * (40 + 8 + 64) + 16 * 32 + 8 * 32 + 16 * 32 + 512;
        for (int it = gw; it < NIT; it += NGW) {
            int r = it;
            TJOB(a.in[7], 2 * DFF, 1024, 0, 2 * DFF, w1in, 1024, 1)
            TJOB(a.in[8], DM, DFF, 0, DM, w1out, DFF, 0)
            TJOB(a.in[16], 2 * DFF, 1024, 0, 2 * DFF, w2in, 1024, 1)
            TJOB(a.in[17], DM, DFF, 0, DM, w2out, DFF, 0)
            TJOB(a.in[10], 4096, 1024, 0, 1280, winm, 1024, 0)
            TJOB(a.in[10], 4096, 1024, 1280, 256, wint, 1024, 0)
            TJOB(a.in[10], 4096, 1024, 2048, 2048, winm + (size_t)1280 * 1024, 1024, 0)
            TJOB(a.in[12], DM, 1024, 0, DM, wa, 1024, 0)
            TJOB(a.in[13], DM, 512, 0, DM, wf, 512, 0)
            TJOB(a.in[14], DM, 1024, 0, DM, wo, 1024, 0)
            fold_item(a.in[10], wint, r, scr, tab, lane);
        }
#undef TJOB
    }
    {
        bf16_t* dft = (bf16_t*)(ws + WS_DFT);
        const int nthr = G * 512;
        for (int idx = blockIdx.x * 512 + tid; idx < 1024 * 256; idx += nthr) {
            const int k = idx >> 8, ch = idx & 255, n0 = (ch * 8) & 1023; const bool sn = ch >= 128;
            float v[8];
#pragma unroll
            for (int e = 0; e < 8; ++e) { const float x = (float)((k * (n0 + e)) & 1023) * (1.0f / 512.0f); v[e] = sn ? sinpif(x) : cospif(x); }
            u32x4 o; o.x = cvt_pk_bf16(v[0], v[1]); o.y = cvt_pk_bf16(v[2], v[3]); o.z = cvt_pk_bf16(v[4], v[5]); o.w = cvt_pk_bf16(v[6], v[7]);
            *(u32x4*)(dft + (size_t)idx * 8) = o;
        }
    }
}

template <int MODE>
__device__ __forceinline__ void norm_phase(const Args& a, const float* xlat, const float* xctx, int nrows, const float* gvec, int midx, bf16_t* hout, float* fout, const int wv, const float* part = nullptr) {
    const int tid = TID_FRESH(wv), lane = tid & 63, wave = wv;
    const int gw = blockIdx.x * 8 + wave, NGW = gridDim.x * 8;
    const int rpw = (nrows + NGW - 1) / NGW;
    const int r_lo = gw * rpw, r_hi = min(nrows, r_lo + rpw);
    const float* modp = (const float*)(a.ws + WS_MODP); const float* mod = (const float*)(a.ws + WS_MOD); const float* bada = a.in[5];
    int curb = -1; f32x4 A[4], Bv[4];
    for (int row = r_lo; row < r_hi; ++row) {
        const bool isctx = row >= NLAT; const int b = isctx ? 16 : (row >> 12);
        if (b != curb) {
            curb = b;
#pragma unroll
            for (int j = 0; j < 4; ++j) {
                const int c = 4 * lane + 256 * j; const f32x4 g4 = *(const f32x4*)(gvec + c);
                if (MODE == 2) { A[j] = g4; Bv[j] = (f32x4){0.f, 0.f, 0.f, 0.f}; }
                else {
                    f32x4 sh, sc;
                    if (MODE == 0) {
                        sh = *(const f32x4*)(bada + midx * DM + c); sc = *(const f32x4*)(bada + (midx + 1) * DM + c);
#pragma unroll
                        for (int s = 0; s < 8; ++s) { sh += *(const f32x4*)(modp + (size_t)(s * 17 + b) * MODW + midx * DM + c); sc += *(const f32x4*)(modp + (size_t)(s * 17 + b) * MODW + (midx + 1) * DM + c); }
                    } else { sh = *(const f32x4*)(mod + (size_t)b * MODW + midx * DM + c); sc = *(const f32x4*)(mod + (size_t)b * MODW + (midx + 1) * DM + c); }
                    A[j] = g4 * (sc + 1.0f); Bv[j] = sh;
                }
            }
        }
        const float* xr = isctx ? xctx + (size_t)(row - NLAT) * DM : xlat + (size_t)row * DM;
        f32x4 v[4]; float ss = 0.f;
#pragma unroll
        for (int j = 0; j < 4; ++j) {
            v[j] = *(const f32x4*)(xr + 4 * lane + 256 * j);
            if (MODE == 1 && part != nullptr && isctx) {
                const size_t po = (size_t)(row - NLAT) * DM + 4 * lane + 256 * j;
                const f32x4 ps = (*(const f32x4*)(part + po) + *(const f32x4*)(part + (size_t)NCTX * DM + po)) + (*(const f32x4*)(part + (size_t)2 * NCTX * DM + po) + *(const f32x4*)(part + (size_t)3 * NCTX * DM + po));
                v[j] += (*(const f32x4*)(mod + (size_t)16 * MODW + 2 * DM + 4 * lane + 256 * j) * 0.5f) * ps;
            }
            ss += (v[j][0] * v[j][0] + v[j][1] * v[j][1]) + (v[j][2] * v[j][2] + v[j][3] * v[j][3]);
        }
        const float rs = rsqrtf(wave_sum(ss) * (1.0f / DM) + RMS_EPS);
#pragma unroll
        for (int j = 0; j < 4; ++j) {
            const f32x4 o = (v[j] * rs) * A[j] + Bv[j];
            if (MODE == 2) *(f32x4*)(fout + (size_t)row * DM + 4 * lane + 256 * j) = o;
            else { u32x2 w; w.x = cvt_pk_bf16(o[0], o[1]); w.y = cvt_pk_bf16(o[2], o[3]); *(u32x2*)(hout + (size_t)row * DM + 4 * lane + 256 * j) = w; }
        }
    }
}

__device__ __forceinline__ void attn_phase(LAS unsigned char* lds, const bf16_t* q, const bf16_t* k, const bf16_t* vt, const bf16_t* kc, const bf16_t* vtc, const float* sink, bf16_t* aout, const int wv) {
    const int tid = TID_FRESH(wv), wid = wv, lane = tid & 63, g = lane >> 4, lq = lane & 15;
    const int hw = wid >> 2, r0 = (wid & 3) * 32;
    const int srow = tid >> 3, sch = tid & 7;
    const int wj0 = (r0 >= 64) ? 1 : 0;
    const unsigned soff = srow * 144 + sch * 16;
    constexpr int VOFF = 6 * 9216;
    u32x4 kreg[6], vreg[6];
#define ATT_LOAD_LOCAL(IT) do { const int hp_ = (IT) & 1, kvh_ = ((IT) >> 1) & 3, qb_ = ((IT) >> 3) & 31, b_ = (IT) >> 8; (void)hp_; \
        const int jl0_ = (qb_ == 0) ? 2 : 0, jl1_ = (qb_ == 31) ? 3 : 5; \
        const bf16_t* kbase_ = k + (size_t)(b_ * SEQ + srow) * 256 + kvh_ * 64 + sch * 8; \
        const bf16_t* vbase_ = vt + (size_t)(kvh_ * 64 + srow) * NLAT + (size_t)b_ * SEQ + sch * 8; \
        _Pragma("unroll") for (int t_ = 0; t_ < 6; ++t_) if (jl0_ + t_ <= jl1_) { const int kp0_ = qb_ * 128 - 128 + 64 * (jl0_ + t_); kreg[t_] = *(const u32x4*)(kbase_ + (size_t)kp0_ * 256); vreg[t_] = *(const u32x4*)(vbase_ + kp0_); } } while (0)
    if ((int)blockIdx.x < 4096) ATT_LOAD_LOCAL((int)blockIdx.x);
    for (int item = blockIdx.x; item < 4096; item += gridDim.x) {
        const int hp = item & 1, kvh = (item >> 1) & 3, qb = (item >> 3) & 31, b = item >> 8;
        const int h = kvh * 4 + hp * 2 + hw, start = qb * 128;
        const int jl0 = (qb == 0) ? 2 : 0, jl1 = (qb == 31) ? 3 : 5, nloc = jl1 - jl0 + 1;
        __syncthreads();
#pragma unroll
        for (int t = 0; t < 6; ++t) if (t < nloc) { *(LAS u32x4*)(lds + t * 9216 + soff) = kreg[t]; *(LAS u32x4*)(lds + VOFF + t * 9216 + soff) = vreg[t]; }
        bf16x8 qf[2][2];
#pragma unroll
        for (int qt = 0; qt < 2; ++qt)
#pragma unroll
            for (int ks = 0; ks < 2; ++ks) qf[qt][ks] = *(const bf16x8*)(q + (size_t)(b * SEQ + start + r0 + 16 * qt + lq) * 1024 + h * 64 + 32 * ks + 8 * g);
        const float sk = sink[h] * LOG2E;
        float mrun[2] = {sk, sk}, lrun[2] = {g == 0 ? 1.f : 0.f, g == 0 ? 1.f : 0.f};
        f32x4 o[4][2];
#pragma unroll
        for (int dt = 0; dt < 4; ++dt)
#pragma unroll
            for (int qt = 0; qt < 2; ++qt) o[dt][qt] = (f32x4){0.f, 0.f, 0.f, 0.f};
        __syncthreads();
        {
            const bf16_t* kcbase = kc + (size_t)(b * CTXL + srow) * 256 + kvh * 64 + sch * 8;
            const bf16_t* vcbase = vtc + (size_t)(kvh * 64 + srow) * NCTX + b * CTXL + sch * 8;
#pragma unroll
            for (int t = 0; t < 4; ++t) { kreg[t] = *(const u32x4*)(kcbase + (size_t)(64 * t) * 256); vreg[t] = *(const u32x4*)(vcbase + 64 * t); }
        }
        auto tile = [&](const int slot, const bool domask, const int jrel) {
            const LAS unsigned char* kb = lds + slot * 9216; const LAS unsigned char* vb = lds + VOFF + slot * 9216;
            f32x4 s[4][2];
#pragma unroll
            for (int kt = 0; kt < 4; ++kt) {
                const bf16x8 k0 = *(const LAS bf16x8*)(kb + (16 * kt + lq) * 144 + (8 * g) * 2), k1 = *(const LAS bf16x8*)(kb + (16 * kt + lq) * 144 + (32 + 8 * g) * 2);
#pragma unroll
                for (int qt = 0; qt < 2; ++qt) {
                    f32x4 z = (f32x4){0.f, 0.f, 0.f, 0.f};
                    z = __builtin_amdgcn_mfma_f32_16x16x32_bf16(k0, qf[qt][0], z, 0, 0, 0);
                    s[kt][qt] = __builtin_amdgcn_mfma_f32_16x16x32_bf16(k1, qf[qt][1], z, 0, 0, 0);
                }
            }
            if (domask) {
                const int kp0 = -128 + 64 * jrel + 4 * g;
#pragma unroll
                for (int kt = 0; kt < 4; ++kt)
#pragma unroll
                    for (int qt = 0; qt < 2; ++qt)
#pragma unroll
                        for (int r = 0; r < 4; ++r) { const int d = (kp0 + 16 * kt + r) - (r0 + 16 * qt + lq); if (d > 128 || d < -128) s[kt][qt][r] = -1e30f; }
            }
            bf16x8 pb[2][2];
#pragma unroll
            for (int qt = 0; qt < 2; ++qt) {
                float mx = -3e38f;
#pragma unroll
                for (int kt = 0; kt < 4; ++kt) mx = fmaxf(mx, fmaxf(fmaxf(s[kt][qt][0], s[kt][qt][1]), fmaxf(s[kt][qt][2], s[kt][qt][3])));
                mx = fmaxf(mx, __shfl_xor(mx, 16)); mx = fmaxf(mx, __shfl_xor(mx, 32));
                const float mn = fmaxf(mrun[qt], mx), alpha = __builtin_amdgcn_exp2f(mrun[qt] - mn);
                mrun[qt] = mn;
                float ls = 0.f;
#pragma unroll
                for (int kt = 0; kt < 4; ++kt)
#pragma unroll
                    for (int r = 0; r < 4; ++r) { const float p = __builtin_amdgcn_exp2f(s[kt][qt][r] - mn); s[kt][qt][r] = p; ls += p; }
                lrun[qt] = lrun[qt] * alpha + ls;
#pragma unroll
                for (int dt = 0; dt < 4; ++dt) o[dt][qt] *= alpha;
#pragma unroll
                for (int kp = 0; kp < 2; ++kp) {
                    u32x4 w; w.x = cvt_pk_bf16(s[2 * kp][qt][0], s[2 * kp][qt][1]); w.y = cvt_pk_bf16(s[2 * kp][qt][2], s[2 * kp][qt][3]);
                    w.z = cvt_pk_bf16(s[2 * kp + 1][qt][0], s[2 * kp + 1][qt][1]); w.w = cvt_pk_bf16(s[2 * kp + 1][qt][2], s[2 * kp + 1][qt][3]);
                    pb[qt][kp] = __builtin_bit_cast(bf16x8, w);
                }
            }
#pragma unroll
            for (int dt = 0; dt < 4; ++dt)
#pragma unroll
                for (int kp = 0; kp < 2; ++kp) {
                    const u32x2 va = *(const LAS u32x2*)(vb + (16 * dt + lq) * 144 + (32 * kp + 4 * g) * 2), vc = *(const LAS u32x2*)(vb + (16 * dt + lq) * 144 + (32 * kp + 16 + 4 * g) * 2);
                    u32x4 vw; vw.x = va.x; vw.y = va.y; vw.z = vc.x; vw.w = vc.y;
                    const bf16x8 vf = __builtin_bit_cast(bf16x8, vw);
#pragma unroll
                    for (int qt = 0; qt < 2; ++qt) o[dt][qt] = __builtin_amdgcn_mfma_f32_16x16x32_bf16(vf, pb[qt][kp], o[dt][qt], 0, 0, 0);
                }
        };
        for (int t = 0; t < nloc; ++t) { const int j = jl0 + t; if (j >= wj0 && j <= wj0 + 4) tile(t, j == wj0 || j == wj0 + 4, j); }
        __syncthreads();
#pragma unroll
        for (int t = 0; t < 4; ++t) { *(LAS u32x4*)(lds + t * 9216 + soff) = kreg[t]; *(LAS u32x4*)(lds + VOFF + t * 9216 + soff) = vreg[t]; }
        __syncthreads();
        if (item + (int)gridDim.x < 4096) ATT_LOAD_LOCAL(item + (int)gridDim.x);
        for (int t = 0; t < 4; ++t) tile(t, false, 0);
#pragma unroll
        for (int qt = 0; qt < 2; ++qt) {
            float lt = lrun[qt]; lt += __shfl_xor(lt, 16); lt += __shfl_xor(lt, 32);
            const float inv = 1.0f / lt;
            bf16_t* orow = aout + (size_t)(b * SEQ + start + r0 + 16 * qt + lq) * 1024 + h * 64 + 4 * g;
#pragma unroll
            for (int dt = 0; dt < 4; ++dt) { const f32x4 ov = o[dt][qt] * inv; u32x2 w; w.x = cvt_pk_bf16(ov[0], ov[1]); w.y = cvt_pk_bf16(ov[2], ov[3]); *(u32x2*)(orow + 16 * dt) = w; }
        }
    }
#undef ATT_LOAD_LOCAL
}

#define XB_TMO      128
#define XB_XCNT(j)  (256  + 64 * (j))
#define XB_XSUB(j)  (1280 + 64 * (j))
#define XB_XGEN(j)  (2304 + 64 * (j))
#define XB_TOP      3328
#define XB_TOPGEN   3392
#define XCD_BAR_WORDS 3456
#define XB_SPIN_CAP (1u << 18)
__device__ __forceinline__ unsigned xb_ld(unsigned* p)              { return __hip_atomic_load(p, __ATOMIC_RELAXED, __HIP_MEMORY_SCOPE_AGENT); }
__device__ __forceinline__ unsigned xb_add(unsigned* p, unsigned v) { return __hip_atomic_fetch_add(p, v, __ATOMIC_RELAXED, __HIP_MEMORY_SCOPE_AGENT); }
__device__ __forceinline__ unsigned xb_xcc_id() { return (unsigned)__builtin_amdgcn_s_getreg((3 << 11) | 20) & 0xFu; }
#define XB_SPIN(cond, bar) do { unsigned _sp = 0; while (cond) { __builtin_amdgcn_s_sleep(1); \
    if ((++_sp & 255u) == 0u) { if (xb_ld(&(bar)[XB_TMO])) break; if (_sp > XB_SPIN_CAP) { atomicAdd(&(bar)[XB_TMO], 1u); break; } } } } while (0)
struct XcdBarrier { unsigned* bar; unsigned x; volatile LAS unsigned* st; };
__device__ __forceinline__ XcdBarrier xcd_barrier_post(unsigned* bar, volatile LAS unsigned* st, const int wv) {
    XcdBarrier b; b.bar = bar; b.x = xb_xcc_id(); b.st = st;
    if (TID_FRESH(wv) == 0) (void)xb_add(&bar[XB_XCNT(b.x)], 1u);
    return b;
}
__device__ __forceinline__ void xcd_barrier_complete(unsigned* bar, unsigned x, unsigned& nloc, unsigned& nx) {
    const unsigned G = gridDim.x * gridDim.y * gridDim.z;
    unsigned sum, cnt, mine, sp = 0u;
    for (;;) {
        sum = 0u; cnt = 0u; mine = 0u;
#pragma unroll
        for (unsigned j = 0; j < 16; ++j) { const unsigned c = xb_ld(&bar[XB_XCNT(j)]); sum += c; cnt += (c > 0u) ? 1u : 0u; mine = (j == x) ? c : mine; }
        if (sum == G) break;
        __builtin_amdgcn_s_sleep(1);
        if ((++sp & 255u) == 0u) { if (xb_ld(&bar[XB_TMO])) break; if (sp > XB_SPIN_CAP) { atomicAdd(&bar[XB_TMO], 1u); break; } }
    }
    nloc = mine > 0u ? mine : 1u; nx = cnt > 0u ? cnt : 1u;
}
__device__ __forceinline__ void xcd_barrier(const XcdBarrier& b, const int wv) {
    asm volatile("s_waitcnt vmcnt(0)" ::: "memory");
    __syncthreads();
    if (TID_FRESH(wv) == 0) {
        unsigned* bar = b.bar;
        __builtin_amdgcn_s_waitcnt(0);
        unsigned nloc = b.st[0], nx = b.st[1];
        if (nloc == 0u) { xcd_barrier_complete(bar, b.x, nloc, nx); b.st[0] = nloc; b.st[1] = nx; }
        const unsigned old = xb_add(&bar[XB_XSUB(b.x)], 1u);
        const unsigned gen = old / nloc;
        if (old + 1u == (gen + 1u) * nloc) {
            __builtin_amdgcn_fence(__ATOMIC_RELEASE, "agent");
            asm volatile("s_waitcnt vmcnt(0)" ::: "memory");
            const unsigned og = xb_add(&bar[XB_TOP], 1u);
            const unsigned tg = og / nx;
            if (og + 1u == (tg + 1u) * nx) xb_add(&bar[XB_TOPGEN], 1u);
            else XB_SPIN(xb_ld(&bar[XB_TOPGEN]) == tg, bar);
            __builtin_amdgcn_fence(__ATOMIC_ACQUIRE, "agent");
            xb_add(&bar[XB_XGEN(b.x)], 1u);
            asm volatile("s_waitcnt vmcnt(0)" ::: "memory");
        } else {
            XB_SPIN(xb_ld(&bar[XB_XGEN(b.x)]) == gen, bar);
            __builtin_amdgcn_fence(__ATOMIC_ACQUIRE, "agent");
            asm volatile("s_waitcnt vmcnt(0)" ::: "memory");
        }
    }
    __syncthreads();
}

constexpr int NPHASE = 13;
__global__ void __launch_bounds__(512) fwd_megakernel(Args a) {
    extern __shared__ __attribute__((aligned(16))) unsigned char lds_raw[];
    LAS unsigned char* lds = (LAS unsigned char*)lds_raw;
    cg::grid_group grid = cg::this_grid();
    const int wv = __builtin_amdgcn_readfirstlane((int)threadIdx.x >> 6);
    volatile LAS unsigned* xst = (volatile LAS unsigned*)(lds + 131072);
    if (TID_FRESH(wv) == 0) { xst[0] = 0u; xst[1] = 0u; }
    __syncthreads();
    XcdBarrier xbar; xbar.bar = (unsigned*)(a.ws + WS_BAR); xbar.x = 0; xbar.st = xst;
    if (a.ph_hi - a.ph_lo > 1) xbar = xcd_barrier_post((unsigned*)(a.ws + WS_BAR), xst, wv);
#define DEF_PTRS \
    unsigned char* ws = a.ws; float* outp = a.out; asm volatile("" : "+s"(ws), "+s"(outp)); \
    const bf16_t* w1in = (const bf16_t*)(ws + WS_W1IN); const bf16_t* w1out = (const bf16_t*)(ws + WS_W1OUT); const bf16_t* w2in = (const bf16_t*)(ws + WS_W2IN); const bf16_t* w2out = (const bf16_t*)(ws + WS_W2OUT); \
    const bf16_t* winm = (const bf16_t*)(ws + WS_WINM); const bf16_t* wint = (const bf16_t*)(ws + WS_WINT); const bf16_t* wa = (const bf16_t*)(ws + WS_WA); const bf16_t* wf = (const bf16_t*)(ws + WS_WF); const bf16_t* wo = (const bf16_t*)(ws + WS_WO); \
    const bf16_t* dft = (const bf16_t*)(ws + WS_DFT); \
    float* mod = (float*)(ws + WS_MOD); const float* rope = (const float*)(ws + WS_ROPE); \
    bf16_t* hbuf = (bf16_t*)(ws + WS_H); bf16_t* act = (bf16_t*)(ws + WS_ACT); float* X = (float*)(ws + WS_X); \
    bf16_t* qb_ = (bf16_t*)(ws + WS_ACT + AO_Q); bf16_t* kb_ = (bf16_t*)(ws + WS_ACT + AO_K); bf16_t* vtb = (bf16_t*)(ws + WS_ACT + AO_VT); bf16_t* pqt = (bf16_t*)(ws + WS_ACT + AO_PQT); \
    bf16_t* fb = (bf16_t*)(ws + WS_F); bf16_t* kcb = (bf16_t*)(ws + WS_ACT + AO_KC); bf16_t* vtcb = (bf16_t*)(ws + WS_ACT + AO_VTC); \
    float* stash = (float*)(ws + WS_ACT); \
    bf16_t* gab = (bf16_t*)outp; bf16_t* gfb = gab + (size_t)NLAT * DM; \
    bf16_t* ab = hbuf; \
    (void)w1in; (void)w1out; (void)w2in; (void)w2out; (void)winm; (void)wint; (void)wa; (void)wf; (void)wo; (void)dft; (void)mod; (void)rope; (void)hbuf; (void)act; (void)X; (void)qb_; (void)kb_; (void)vtb; (void)pqt; (void)fb; (void)kcb; (void)vtcb; (void)stash; (void)gab; (void)gfb; (void)ab;
#define RUN(N) (a.ph_lo <= (N) && (N) < a.ph_hi)
#define SYNC_AFTER(N) if (a.ph_lo <= (N) && (N) + 1 < a.ph_hi) { if (a.ph_hi > NPHASE) grid.sync(); else xcd_barrier(xbar, wv); }
#define STEP_BEGIN { DEF_PTRS
#define STEP_END }

    if (RUN(0)) { phase_prep(a, lds, wv); }
    SYNC_AFTER(0)
    if (RUN(1)) STEP_BEGIN
        const float* modp = (const float*)(ws + WS_MODP); const float* bada = a.in[5];
        for (int i = blockIdx.x * 512 + TID_FRESH(wv); i < 17 * MODW; i += gridDim.x * 512) { float s = bada[i % MODW];
#pragma unroll
            for (int sp = 0; sp < 8; ++sp) s += modp[(size_t)sp * 17 * MODW + i]; mod[i] = s; }
        norm_phase<0>(a, a.in[0], a.in[2], NTOK, a.in[6], 0, hbuf, nullptr, wv);
    STEP_END
    SYNC_AFTER(1)
    if (RUN(2)) STEP_BEGIN Gemm g{hbuf, w1in, DM, DM, DM, NTOK / 256, 22, 1 << 30, 0, 0, 0}; EpiSwiglu e{act}; gemm_phase(lds, g, e, wv); STEP_END
    SYNC_AFTER(2)
    if (RUN(3)) {
        STEP_BEGIN Gemm g{act, w1out, DFF, DFF, DFF, 256, 4, 1 << 30, 0, 0, 0}; EpiResid e{a.in[0], a.in[2], X, mod, 2, 0.5f}; gemm_phase(lds, g, e, wv); STEP_END
        STEP_BEGIN Gemm g{act + (size_t)NLAT * DFF, w1out, DFF, DFF, 768, 48, 4, 16, 768, 768, 0}; EpiPartial e{(float*)(ws + WS_PART)}; gemm_phase(lds, g, e, wv); STEP_END
        STEP_BEGIN Gemm g{act + (size_t)NLAT * DFF + 2304, w1out + 2304, DFF, DFF, 512, 16, 4, 1 << 30, 0, 0, 192}; EpiPartial e{(float*)(ws + WS_PART) + (size_t)3 * NCTX * DM}; gemm_phase(lds, g, e, wv); STEP_END
    }
    SYNC_AFTER(3)
    if (RUN(4)) STEP_BEGIN norm_phase<1>(a, X, a.in[2], NTOK, a.in[9], 3, hbuf, nullptr, wv, (const float*)(ws + WS_PART)); STEP_END
    SYNC_AFTER(4)
    if (RUN(5)) {
        STEP_BEGIN Gemm g{hbuf, winm, DM, DM, DM, 256, 13, 1 << 30, 0, 0, 0}; EpiQKG e{qb_, kb_, gab, gfb, rope}; gemm_phase(lds, g, e, wv); STEP_END
        STEP_BEGIN Gemm g{wint + (size_t)256 * DM, hbuf, DM, DM, DM, 4, 256, 1 << 30, 0, 0, 0}; EpiFFT1 e{pqt}; gemm_phase(lds, g, e, wv); STEP_END
        STEP_BEGIN Gemm g{wint, hbuf, DM, DM, DM, 1, 256, 1 << 30, 0, 0, 0}; EpiT<true> e{vtb, NLAT, vtb}; gemm_phase(lds, g, e, wv); STEP_END
        STEP_BEGIN Gemm g{hbuf + (size_t)NLAT * DM, winm + (size_t)1024 * DM, DM, DM, DM, 16, 1, 1 << 30, 0, 0, 0}; EpiPlain e{kcb, 256, 1.0f}; gemm_phase(lds, g, e, wv); STEP_END
        STEP_BEGIN Gemm g{wint, hbuf + (size_t)NLAT * DM, DM, DM, DM, 1, 16, 1 << 30, 0, 0, 128}; EpiT<true> e{vtcb, NCTX, vtcb}; gemm_phase(lds, g, e, wv); STEP_END
    }
    SYNC_AFTER(5)
    if (RUN(6)) {
        STEP_BEGIN attn_phase(lds, qb_, kb_, vtb, kcb, vtcb, a.in[11], ab, wv); STEP_END
        __syncthreads();
        STEP_BEGIN Gemm g{dft, pqt, 2048, 2048, 2048, 256, 2, 4, (size_t)512 * 2048, 0, 0}; EpiFFT2 e{fb}; gemm_phase(lds, g, e, wv); STEP_END
    }
    SYNC_AFTER(6)
    if (RUN(7)) {
        STEP_BEGIN Gemm g{ab, wa, DM, DM, DM, 256, 4, 1 << 30, 0, 0, 0}; EpiMerge<1> e{stash, gab}; gemm_phase(lds, g, e, wv); STEP_END
        STEP_BEGIN Gemm g{fb, wf, 512, 512, 512, 256, 4, 1 << 30, 0, 0, 0}; EpiMerge<2> e{stash, gfb}; gemm_phase(lds, g, e, wv); STEP_END
    }
    SYNC_AFTER(7)
    if (RUN(8)) STEP_BEGIN Gemm g{gfb, wo, DM, DM, DM, 256, 4, 1 << 30, 0, 0, 0}; EpiResid e{X, X, X, mod, 5, 1.0f}; gemm_phase(lds, g, e, wv); STEP_END
    SYNC_AFTER(8)
    if (RUN(9)) STEP_BEGIN norm_phase<1>(a, X, X, NLAT, a.in[15], 6, hbuf, nullptr, wv); STEP_END
    SYNC_AFTER(9)
    if (RUN(10)) STEP_BEGIN Gemm g{hbuf, w2in, DM, DM, DM, 256, 22, 1 << 30, 0, 0, 0}; EpiSwiglu e{act}; gemm_phase(lds, g, e, wv); STEP_END
    SYNC_AFTER(10)
    if (RUN(11)) STEP_BEGIN Gemm g{act, w2out, DFF, DFF, DFF, 256, 4, 1 << 30, 0, 0, 0}; EpiResid e{X, X, outp, mod, 8, 0.5f}; gemm_phase(lds, g, e, wv); STEP_END
    SYNC_AFTER(11)
    if (RUN(12)) STEP_BEGIN norm_phase<2>(a, outp, outp, NLAT, a.in[18], 0, nullptr, outp, wv); STEP_END
}

extern "C" void kernel_launch(void* const* d_in, const int* in_sizes, int n_in, void* d_out, int out_size, void* d_ws, size_t ws_size, hipStream_t stream) {
    static int grid_blocks = 0;
    if (grid_blocks == 0) {
        if (n_in != 19 || out_size != NLAT * DM || ws_size < WS_END) { fprintf(stderr, "kernel_launch: unexpected shapes (n_in %d out %d ws %zu need %zu)\n", n_in, out_size, ws_size, (size_t)WS_END); grid_blocks = -1; return; }
        int dev = 0, cus = 0, per_cu = 0;
        (void)hipGetDevice(&dev);
        (void)hipDeviceGetAttribute(&cus, hipDeviceAttributeMultiprocessorCount, dev);
        if (hipFuncSetAttribute((const void*)fwd_megakernel, hipFuncAttributeMaxDynamicSharedMemorySize, LDS_BYTES) != hipSuccess) { fprintf(stderr, "kernel_launch: hipFuncSetAttribute failed\n"); grid_blocks = -1; return; }
        if (hipOccupancyMaxActiveBlocksPerMultiprocessor(&per_cu, (const void*)fwd_megakernel, 512, LDS_BYTES) != hipSuccess || per_cu < 1) { fprintf(stderr, "kernel_launch: occupancy query says %d blocks per CU\n", per_cu); per_cu = 1; (void)hipGetLastError(); }
        grid_blocks = cus;
        (void)per_cu;
    }
    if (grid_blocks < 0) return;
    Args a{};
    for (int i = 0; i < 19; ++i) a.in[i] = (const float*)d_in[i];
    a.out = (float*)d_out; a.ws = (unsigned char*)d_ws;
#if N_LAUNCH_PER_PHASE
    for (int ph = 0; ph < NPHASE; ++ph) {
        a.ph_lo = ph; a.ph_hi = ph + 1;
        hipLaunchKernelGGL(fwd_megakernel, dim3(grid_blocks), dim3(512), LDS_BYTES, stream, a);
    }
#else
    a.ph_lo = 0; a.ph_hi = NPHASE;
    if (hipMemsetAsync((char*)d_ws + WS_BAR, 0, 16384, stream) != hipSuccess) { fprintf(stderr, "kernel_launch: memset of the barrier words failed\n"); return; }
    void* args[] = {&a};
    hipError_t e = hipLaunchCooperativeKernel((const void*)fwd_megakernel, dim3(grid_blocks), dim3(512), args, LDS_BYTES, stream);
    if (e != hipSuccess) fprintf(stderr, "kernel_launch: cooperative launch failed: %s (grid %d)\n", hipGetErrorString(e), grid_blocks);
#endif
}
```

```cpp
#include <hip/hip_runtime.h>
#include <hip/hip_cooperative_groups.h>
#include <cstdio>
#include <cstdint>
namespace cg = cooperative_groups;

#ifndef N_LAUNCH_PER_PHASE
#define N_LAUNCH_PER_PHASE 0
#endif

#define LAS __attribute__((address_space(3)))
typedef unsigned short bf16_t;
typedef short bf16x8 __attribute__((ext_vector_type(8)));
typedef float f32x4 __attribute__((ext_vector_type(4)));
typedef float f32x2 __attribute__((ext_vector_type(2)));
typedef unsigned u32x4 __attribute__((ext_vector_type(4)));
typedef unsigned u32x2 __attribute__((ext_vector_type(2)));

constexpr int DM = 1024, NB = 16, SEQ = 4096, CTXL = 256, DFF = 2816, NMOD = 9;
constexpr int NLAT = NB * SEQ;
constexpr int NCTX = NB * CTXL;
constexpr int NTOK = NLAT + NCTX;
constexpr int MODW = NMOD * DM;
constexpr float LOG2E = 1.4426950408889634f;
constexpr float QSCALE = 0.125f * LOG2E;
constexpr float RMS_EPS = 1e-6f;

constexpr size_t WS_W1IN = 0;
constexpr size_t WS_W1OUT = WS_W1IN + (size_t)2 * DFF * DM * 2;
constexpr size_t WS_W2IN = WS_W1OUT + (size_t)DM * DFF * 2;
constexpr size_t WS_W2OUT = WS_W2IN + (size_t)2 * DFF * DM * 2;
constexpr size_t WS_WINM = WS_W2OUT + (size_t)DM * DFF * 2;
constexpr size_t WS_WINT = WS_WINM + (size_t)3328 * DM * 2;
constexpr size_t WS_WA = WS_WINT + (size_t)1280 * DM * 2;
constexpr size_t WS_WF = WS_WA + (size_t)DM * DM * 2;
constexpr size_t WS_WO = WS_WF + (size_t)DM * 512 * 2;
constexpr size_t WS_DFT = WS_WO + (size_t)DM * DM * 2;
constexpr size_t WS_MODP = WS_DFT + (size_t)1024 * 2048 * 2;
constexpr size_t WS_MOD = WS_MODP + (size_t)8 * 17 * MODW * 4;
constexpr size_t WS_ROPE = WS_MOD + (size_t)17 * MODW * 4;
constexpr size_t WS_H = WS_ROPE + 8192;
constexpr size_t WS_ACT = WS_H + (size_t)NTOK * DM * 2;
constexpr size_t WS_X = WS_ACT + (size_t)NTOK * DFF * 2;
constexpr size_t WS_F = WS_X + (size_t)NTOK * DM * 4;
constexpr size_t WS_BAR = WS_F + (size_t)NLAT * 512 * 2;
constexpr size_t WS_PART = WS_BAR + 16384;
constexpr size_t WS_END = WS_PART + (size_t)4 * NCTX * DM * 4;
constexpr size_t AO_Q = 0;
constexpr size_t AO_K = AO_Q + (size_t)NLAT * 1024 * 2;
constexpr size_t AO_VT = AO_K + (size_t)NLAT * 256 * 2;
constexpr size_t AO_PQT = AO_VT + (size_t)256 * NLAT * 2;
constexpr size_t AO_KC = AO_PQT + (size_t)512 * NB * 8192 * 2;
constexpr size_t AO_VTC = AO_KC + (size_t)NCTX * 256 * 2;
static_assert(AO_KC >= (size_t)NLAT * 1024 * 4, "the f32 merge stash may only overlay q, k, V^T, PQ^T");
static_assert(WS_END <= (size_t)1073741824, "workspace");
static_assert(AO_VTC + (size_t)256 * NCTX * 2 <= (size_t)NTOK * DFF * 2, "act alias");

constexpr int LDS_BYTES = 131072 + 16;

__device__ __forceinline__ unsigned cvt_pk_bf16(float lo, float hi) { unsigned r; asm volatile("v_cvt_pk_bf16_f32 %0, %1, %2" : "=v"(r) : "v"(lo), "v"(hi)); return r; }
__device__ __forceinline__ float bf_lo(unsigned w) { return __uint_as_float(w << 16); }
__device__ __forceinline__ float bf_hi(unsigned w) { return __uint_as_float(w & 0xffff0000u); }
__device__ __forceinline__ float fast_sigmoid(float v) { return __builtin_amdgcn_rcpf(1.0f + __builtin_amdgcn_exp2f(-v * LOG2E)); }
__device__ __forceinline__ float wave_sum(float v) {
#pragma unroll
    for (int o = 1; o < 64; o <<= 1) v += __shfl_xor(v, o);
    return v;
}
#define LDS_WAIT() asm volatile("s_waitcnt lgkmcnt(0)" ::: "memory")
__device__ __forceinline__ int lane_id_fresh() { int l = (int)__builtin_amdgcn_mbcnt_hi(~0u, __builtin_amdgcn_mbcnt_lo(~0u, 0u)); asm volatile("" : "+v"(l)); return l; }
#define TID_FRESH(wv) ((int)((wv) << 6) | lane_id_fresh())

namespace pg8 {
constexpr int BM = 256, BK = 64, HALF = 128, HTB = HALF * BK * 2, NXCD = 8, WGM = 8;
__host__ __device__ __forceinline__ int lds_byte(int r, int c) { const int st = (r >> 4) * 2 + (c >> 5), rr = r & 15, cc = c & 31, ob = rr * 64 + cc * 2; return st * 1024 + (ob ^ (((ob >> 9) & 1) << 5)); }
__host__ __device__ __forceinline__ void stage_rc(int b, int& R, int& C) { const int st = b / 1024, sb = b % 1024, swz = sb ^ (((sb >> 9) & 1) << 5); R = (st >> 1) * 16 + swz / 64; C = (st & 1) * 32 + (swz % 64) / 2; }
__host__ __device__ __forceinline__ int perm32(int rho) { const int n = rho >> 4, i = rho & 15; return 8 * (i >> 2) + 4 * n + (i & 3); }
struct Unit { int pm, pn; };
struct Gemm { const bf16_t* A; const bf16_t* Bt; int lda, ldb, K, nM, nN, a_mod; size_t b_bstride; size_t a_bstride; int c_off; };
struct StaticOrder {
    int nM, nN, nwg, G, c;
    __device__ __forceinline__ void init(int nM_, int nN_, int G_, int c_) { nM = nM_; nN = nN_; nwg = nM * nN; G = G_; c = c_; }
    __device__ __forceinline__ bool next(int i, Unit& u) const {
        const long L = (long)i * G + c; if (L >= nwg) return false;
        int wgid = (int)L; { const int q = nwg / NXCD, r = nwg % NXCD, xcd = wgid % NXCD, off = wgid / NXCD; wgid = (xcd < r ? xcd * (q + 1) : r * (q + 1) + (xcd - r) * q) + off; }
        const int nig = WGM * nN, gid = wgid / nig, fm = gid * WGM, gsz = (nM - fm) < WGM ? (nM - fm) : WGM;
        u.pm = fm + ((wgid % nig) % gsz); u.pn = (wgid % nig) / gsz; return true;
    }
};
__device__ __forceinline__ const char* unit_a(const Gemm& g, const Unit& u) { return (const char*)g.A + ((size_t)(u.pm % g.a_mod) * BM * (size_t)g.lda + (size_t)(u.pm / g.a_mod) * g.a_bstride) * 2; }
template <int BMODE> __device__ __forceinline__ const char* unit_b(const Gemm& g, const Unit& u) {
    if (BMODE == 2) return (const char*)g.Bt + (size_t)((u.pn >> 4) * 4096 + (u.pn & 15) * 64) * (size_t)g.ldb * 2;
    return (const char*)g.Bt + ((size_t)u.pn * BM * (size_t)g.ldb + (size_t)(u.pm / g.a_mod) * g.b_bstride) * 2; }

template <class Epi>
__device__ __forceinline__ void gemm_phase(LAS unsigned char* lds, const Gemm g, const Epi& E, const int wv) {
    const int tid = TID_FRESH(wv), wid = wv, lane = tid & 63, wr = wid >> 2, wc = wid & 3, fr = lane & 15, fq = lane >> 4;
    const int K = g.K, nt = K / BK;
    StaticOrder S; S.init(g.nM, g.nN, (int)gridDim.x, (int)((blockIdx.x + (unsigned)g.c_off) % gridDim.x));
    unsigned voffA[2], voffB[2];
#pragma unroll
    for (int i = 0; i < 2; ++i) { int R, C; stage_rc(tid * 16 + i * 8192, R, C);
        const int Rb = Epi::BMODE == 1 ? ((R & ~31) + perm32(R & 31)) : (Epi::BMODE == 2 ? (1024 * ((R >> 4) & 1) + 16 * (R >> 5) + (R & 15)) : R);
        voffA[i] = (unsigned)(R * g.lda + C) * 2u; voffB[i] = (unsigned)(Rb * g.ldb + C) * 2u; }
    const size_t kstep = (size_t)(BK * 2);
    const size_t hstepA = (size_t)HALF * g.lda * 2, hstepB = (size_t)(Epi::BMODE == 2 ? 2048 : HALF) * g.ldb * 2;
    const unsigned ldsw = (unsigned)wid * 1024u;
    const int aoff = lds_byte(wr * 64 + fr, fq * 8), boff = lds_byte(wc * 32 + fr, fq * 8);
#define PG8_SA(b, h) (((b) * 2 + (h)) * HTB)
#define PG8_SB(b, h) ((4 + (b) * 2 + (h)) * HTB)
#define PG8_STAGE(bufoff, gbase, voff) do { _Pragma("unroll") for (int _i = 0; _i < 2; ++_i) \
        __builtin_amdgcn_global_load_lds((const unsigned*)((const char*)(gbase) + (voff)[_i]), (LAS unsigned*)(lds + (bufoff) + ldsw + _i * 8192), 16, 0, 0); } while (0)
#define PG8_LDA(dst, b, h) do { _Pragma("unroll") for (int m = 0; m < 4; ++m) _Pragma("unroll") for (int k = 0; k < 2; ++k) dst[m][k] = *(const LAS bf16x8*)(lds + PG8_SA(b, h) + aoff + m * 2048 + k * 1024); } while (0)
#define PG8_LDB(dst, b, h) do { _Pragma("unroll") for (int n = 0; n < 2; ++n) _Pragma("unroll") for (int k = 0; k < 2; ++k) dst[n][k] = *(const LAS bf16x8*)(lds + PG8_SB(b, h) + boff + n * 2048 + k * 1024); } while (0)
#define PG8_MMA(ai, bj, At, Bt) do { __builtin_amdgcn_s_setprio(1); _Pragma("unroll") for (int m = 0; m < 4; ++m) _Pragma("unroll") for (int n = 0; n < 2; ++n) _Pragma("unroll") for (int k = 0; k < 2; ++k) \
        acc[ai][bj][m][n] = __builtin_amdgcn_mfma_f32_16x16x32_bf16(Bt[n][k], At[m][k], acc[ai][bj][m][n], 0, 0, 0); __builtin_amdgcn_s_setprio(0); } while (0)
#define PG8_WAIT_V(n) asm volatile("s_waitcnt vmcnt(" #n ")" ::: "memory")
#define PG8_WAIT_L(n) asm volatile("s_waitcnt lgkmcnt(" #n ")" ::: "memory")
#define PG8_BAR __builtin_amdgcn_s_barrier()
#define PG8_SCHED __builtin_amdgcn_sched_barrier(0)
    Unit cur, nxt; int ui = 0;
    if (!S.next(0, cur)) return;
    f32x4 acc[2][2][4][2];
#pragma unroll
    for (int a = 0; a < 2; ++a)
#pragma unroll
        for (int b = 0; b < 2; ++b)
#pragma unroll
            for (int m = 0; m < 4; ++m)
#pragma unroll
                for (int n = 0; n < 2; ++n) acc[a][b][m][n] = (f32x4){0.f, 0.f, 0.f, 0.f};
    bf16x8 At[4][2], B0[2][2], B1[2][2];
    const char* cA = unit_a(g, cur); const char* cB = unit_b<Epi::BMODE>(g, cur);
    PG8_STAGE(PG8_SB(0, 0), cB, voffB); PG8_STAGE(PG8_SA(0, 0), cA, voffA); PG8_STAGE(PG8_SB(0, 1), cB + hstepB, voffB); PG8_STAGE(PG8_SA(0, 1), cA + hstepA, voffA);
    if (wr == 1) PG8_BAR;
    PG8_WAIT_V(4); PG8_BAR;
    PG8_STAGE(PG8_SB(1, 0), cB + kstep, voffB); PG8_STAGE(PG8_SA(1, 0), cA + kstep, voffA); PG8_STAGE(PG8_SB(1, 1), cB + hstepB + kstep, voffB);
    PG8_WAIT_V(6); PG8_BAR;
    for (;;) {
        const bool has_next = S.next(ui + 1, nxt);
        const char* nA = has_next ? unit_a(g, nxt) : cA; const char* nB = has_next ? unit_b<Epi::BMODE>(g, nxt) : cB;
#pragma nounroll
        for (int t = 0; t < nt; t += 2) {
            const bool last = (t == nt - 2);
            const char* a1 = cA + (size_t)(t + 1) * kstep;
            const char* a2 = last ? nA : cA + (size_t)(t + 2) * kstep; const char* b2 = last ? nB : cB + (size_t)(t + 2) * kstep;
            const char* a3 = a2 + kstep; const char* b3 = b2 + kstep;
            PG8_LDB(B0, 0, 0); PG8_SCHED; PG8_LDA(At, 0, 0); PG8_STAGE(PG8_SA(1, 1), a1 + hstepA, voffA);
            PG8_WAIT_L(8); PG8_BAR; PG8_WAIT_L(0); PG8_MMA(0, 0, At, B0); PG8_BAR; PG8_SCHED;
            PG8_LDB(B1, 0, 1); PG8_STAGE(PG8_SB(0, 0), b2, voffB);
            PG8_BAR; PG8_WAIT_L(0); PG8_MMA(0, 1, At, B1); PG8_BAR;
            PG8_LDA(At, 0, 1); PG8_STAGE(PG8_SA(0, 0), a2, voffA);
            PG8_BAR; PG8_WAIT_L(0); PG8_MMA(1, 0, At, B0); PG8_BAR; PG8_SCHED;
            PG8_STAGE(PG8_SB(0, 1), b2 + hstepB, voffB);
            PG8_WAIT_V(6); PG8_BAR; PG8_MMA(1, 1, At, B1); PG8_BAR;
            PG8_LDB(B0, 1, 0); PG8_SCHED; PG8_LDA(At, 1, 0); PG8_STAGE(PG8_SA(0, 1), a2 + hstepA, voffA);
            PG8_WAIT_L(8); PG8_BAR; PG8_WAIT_L(0); PG8_MMA(0, 0, At, B0); PG8_BAR; PG8_SCHED;
            PG8_LDB(B1, 1, 1); PG8_STAGE(PG8_SB(1, 0), b3, voffB);
            PG8_BAR; PG8_WAIT_L(0); PG8_MMA(0, 1, At, B1); PG8_BAR;
            PG8_LDA(At, 1, 1); PG8_STAGE(PG8_SA(1, 0), a3, voffA);
            PG8_BAR; PG8_WAIT_L(0); PG8_MMA(1, 0, At, B0); PG8_BAR; PG8_SCHED;
            PG8_STAGE(PG8_SB(1, 1), b3 + hstepB, voffB);
            PG8_WAIT_V(6); PG8_BAR; PG8_MMA(1, 1, At, B1); PG8_BAR;
        }
        E(acc, cur, wr, wc, fr, fq);
        if (!has_next) break;
#pragma unroll
        for (int a = 0; a < 2; ++a)
#pragma unroll
            for (int b = 0; b < 2; ++b)
#pragma unroll
                for (int m = 0; m < 4; ++m)
#pragma unroll
                    for (int n = 0; n < 2; ++n) acc[a][b][m][n] = (f32x4){0.f, 0.f, 0.f, 0.f};
        cur = nxt; cA = nA; cB = nB; ++ui;
    }
    PG8_WAIT_V(0);
    if (wr == 0) PG8_BAR;
    PG8_BAR;
#undef PG8_SA
#undef PG8_SB
#undef PG8_STAGE
#undef PG8_LDA
#undef PG8_LDB
#undef PG8_MMA
#undef PG8_WAIT_V
#undef PG8_WAIT_L
#undef PG8_BAR
#undef PG8_SCHED
}
}
using pg8::Unit; using pg8::Gemm; using pg8::gemm_phase;
typedef f32x4 AccT[2][2][4][2];

struct EpiSwiglu {
    static constexpr int BMODE = 1;
    bf16_t* out;
    __device__ __forceinline__ void operator()(const AccT& acc, const Unit& u, int wr, int wc, int fr, int fq) const {
        const int row0 = u.pm * 256 + wr * 64 + fr, col0 = u.pn * 128 + wc * 32 + 8 * fq;
#pragma unroll
        for (int ai = 0; ai < 2; ++ai)
#pragma unroll
            for (int m = 0; m < 4; ++m) {
                float r[8];
#pragma unroll
                for (int n = 0; n < 2; ++n)
#pragma unroll
                    for (int j = 0; j < 4; ++j) { const float a = acc[ai][0][m][n][j], uu = acc[ai][1][m][n][j]; r[n * 4 + j] = a * fast_sigmoid(a) * uu; }
                u32x4 w; w.x = cvt_pk_bf16(r[0], r[1]); w.y = cvt_pk_bf16(r[2], r[3]); w.z = cvt_pk_bf16(r[4], r[5]); w.w = cvt_pk_bf16(r[6], r[7]);
                *(u32x4*)(out + (size_t)(row0 + ai * 128 + m * 16) * DFF + col0) = w;
            }
    }
};
struct EpiResid {
    static constexpr int BMODE = 0;
    const float* xin_lat; const float* xin_ctx; float* out; const float* mod; int gidx; float gs;
    __device__ __forceinline__ void operator()(const AccT& acc, const Unit& u, int wr, int wc, int fr, int fq) const {
        const int rowt = u.pm * 256; const bool isctx = rowt >= NLAT;
        const float* gate = mod + (size_t)(isctx ? 16 : (rowt >> 12)) * MODW + gidx * DM;
        const float* xin = isctx ? xin_ctx - (size_t)NLAT * DM : xin_lat;
        const int row0 = rowt + wr * 64 + fr, col0 = u.pn * 256 + wc * 32 + 4 * fq;
        f32x4 gv[2][2];
#pragma unroll
        for (int bj = 0; bj < 2; ++bj)
#pragma unroll
            for (int n = 0; n < 2; ++n) gv[bj][n] = *(const f32x4*)(gate + col0 + bj * 128 + n * 16) * gs;
#pragma unroll
        for (int ai = 0; ai < 2; ++ai) {
            f32x4 xv[4][2][2];
#pragma unroll
            for (int m = 0; m < 4; ++m) {
                const size_t off = (size_t)(row0 + ai * 128 + m * 16) * DM + col0;
#pragma unroll
                for (int bj = 0; bj < 2; ++bj)
#pragma unroll
                    for (int n = 0; n < 2; ++n) xv[m][bj][n] = *(const f32x4*)(xin + off + bj * 128 + n * 16);
            }
#pragma unroll
            for (int m = 0; m < 4; ++m) {
                const size_t off = (size_t)(row0 + ai * 128 + m * 16) * DM + col0;
#pragma unroll
                for (int bj = 0; bj < 2; ++bj)
#pragma unroll
                    for (int n = 0; n < 2; ++n) *(f32x4*)(out + off + bj * 128 + n * 16) = xv[m][bj][n] + gv[bj][n] * acc[ai][bj][m][n];
            }
            asm volatile("" ::: "memory");
        }
    }
};
struct EpiQKG {
    static constexpr int BMODE = 1;
    bf16_t* q; bf16_t* k; bf16_t* ga; bf16_t* gf; const float* rope;
    __device__ __forceinline__ void operator()(const AccT& acc, const Unit& u, int wr, int wc, int fr, int fq) const {
        const int row0 = u.pm * 256 + wr * 64 + fr, cl = wc * 32 + 8 * fq;
        if (u.pn <= 4) {
            const bool isq = u.pn < 4; const float sc = isq ? QSCALE : 1.0f;
            bf16_t* dst = isq ? q + u.pn * 256 : k; const int ldc = isq ? 1024 : 256;
#pragma unroll
            for (int ai = 0; ai < 2; ++ai) {
                f32x4 csv[4], snv[4];
#pragma unroll
                for (int m = 0; m < 4; ++m) { const int n = (row0 + ai * 128 + m * 16) & 4095, pos = (wc & 1) ? (n & 63) : (n >> 6);
                    csv[m] = *(const f32x4*)(rope + pos * 16 + 4 * fq); snv[m] = *(const f32x4*)(rope + 1024 + pos * 16 + 4 * fq); }
#pragma unroll
                for (int m = 0; m < 4; ++m) {
                    const int row = row0 + ai * 128 + m * 16;
                    const f32x4 cs = csv[m] * sc, sn = snv[m] * sc;
#pragma unroll
                    for (int bj = 0; bj < 2; ++bj) {
                        const f32x4 v0 = acc[ai][bj][m][0], v1 = acc[ai][bj][m][1];
                        u32x4 w;
                        w.x = cvt_pk_bf16(v0[0] * cs[0] - v0[1] * sn[0], v0[0] * sn[0] + v0[1] * cs[0]);
                        w.y = cvt_pk_bf16(v0[2] * cs[1] - v0[3] * sn[1], v0[2] * sn[1] + v0[3] * cs[1]);
                        w.z = cvt_pk_bf16(v1[0] * cs[2] - v1[1] * sn[2], v1[0] * sn[2] + v1[1] * cs[2]);
                        w.w = cvt_pk_bf16(v1[2] * cs[3] - v1[3] * sn[3], v1[2] * sn[3] + v1[3] * cs[3]);
                        *(u32x4*)(dst + (size_t)row * ldc + bj * 128 + cl) = w;
                    }
                }
            }
        } else {
            bf16_t* dst = (u.pn < 9) ? ga + (u.pn - 5) * 256 : gf + (u.pn - 9) * 256;
#pragma unroll
            for (int ai = 0; ai < 2; ++ai)
#pragma unroll
                for (int m = 0; m < 4; ++m) {
                    const int row = row0 + ai * 128 + m * 16;
#pragma unroll
                    for (int bj = 0; bj < 2; ++bj) {
                        const f32x4 v0 = acc[ai][bj][m][0], v1 = acc[ai][bj][m][1];
                        u32x4 w; w.x = cvt_pk_bf16(v0[0], v0[1]); w.y = cvt_pk_bf16(v0[2], v0[3]); w.z = cvt_pk_bf16(v1[0], v1[1]); w.w = cvt_pk_bf16(v1[2], v1[3]);
                        *(u32x4*)(dst + (size_t)row * 1024 + bj * 128 + cl) = w;
                    }
                }
        }
    }
};
template <bool ONLYV> struct EpiT {
    static constexpr int BMODE = 1;
    bf16_t* vt; int ldv; bf16_t* pqt;
    __device__ __forceinline__ void operator()(const AccT& acc, const Unit& u, int wr, int wc, int fr, int fq) const {
        const int frow0 = u.pm * 256 + wr * 64 + fr, t0 = u.pn * 256 + wc * 32 + 8 * fq;
#pragma unroll
        for (int ai = 0; ai < 2; ++ai)
#pragma unroll
            for (int m = 0; m < 4; ++m) {
                const int frow = frow0 + ai * 128 + m * 16;
                bf16_t* rowp;
                if (ONLYV || u.pm == 0) rowp = vt + (size_t)frow * ldv + t0;
                else { const int fidx = frow - 256, pq = fidx >> 9, col = fidx & 511, b = t0 >> 12, n = t0 & 4095; rowp = pqt + (size_t)col * 131072 + b * 8192 + pq * 4096 + n; }
#pragma unroll
                for (int bj = 0; bj < 2; ++bj) {
                    const f32x4 v0 = acc[ai][bj][m][0], v1 = acc[ai][bj][m][1];
                    u32x4 w; w.x = cvt_pk_bf16(v0[0], v0[1]); w.y = cvt_pk_bf16(v0[2], v0[3]); w.z = cvt_pk_bf16(v1[0], v1[1]); w.w = cvt_pk_bf16(v1[2], v1[3]);
                    *(u32x4*)(rowp + bj * 128) = w;
                }
            }
    }
};
struct EpiPlain {
    static constexpr int BMODE = 1;
    bf16_t* out; int ldc; float scale;
    __device__ __forceinline__ void operator()(const AccT& acc, const Unit& u, int wr, int wc, int fr, int fq) const {
        const int row0 = u.pm * 256 + wr * 64 + fr, col0 = u.pn * 256 + wc * 32 + 8 * fq;
#pragma unroll
        for (int ai = 0; ai < 2; ++ai)
#pragma unroll
            for (int m = 0; m < 4; ++m) {
                bf16_t* rowp = out + (size_t)(row0 + ai * 128 + m * 16) * ldc + col0;
#pragma unroll
                for (int bj = 0; bj < 2; ++bj) {
                    const f32x4 v0 = acc[ai][bj][m][0] * scale, v1 = acc[ai][bj][m][1] * scale;
                    u32x4 w; w.x = cvt_pk_bf16(v0[0], v0[1]); w.y = cvt_pk_bf16(v0[2], v0[3]); w.z = cvt_pk_bf16(v1[0], v1[1]); w.w = cvt_pk_bf16(v1[2], v1[3]);
                    *(u32x4*)(rowp + bj * 128) = w;
                }
            }
    }
};
template <int PASS> struct EpiMerge {
    static constexpr int BMODE = 1;
    float* stash; bf16_t* gate;
    __device__ __forceinline__ void operator()(const AccT& acc, const Unit& u, int wr, int wc, int fr, int fq) const {
        const int row0 = u.pm * 256 + wr * 64 + fr, col0 = u.pn * 256 + wc * 32 + 8 * fq;
#pragma unroll
        for (int ai = 0; ai < 2; ++ai)
#pragma unroll
            for (int mh = 0; mh < 2; ++mh) {
                u32x4 gw[2][2]; f32x4 st0[2][2], st1[2][2];
#pragma unroll
                for (int mm = 0; mm < 2; ++mm)
#pragma unroll
                    for (int bj = 0; bj < 2; ++bj) {
                        const size_t off = (size_t)(row0 + ai * 128 + (mh * 2 + mm) * 16) * DM + col0 + bj * 128;
                        gw[mm][bj] = *(const u32x4*)(gate + off);
                        if (PASS == 2) { st0[mm][bj] = *(const f32x4*)(stash + off); st1[mm][bj] = *(const f32x4*)(stash + off + 4); }
                    }
#pragma unroll
                for (int mm = 0; mm < 2; ++mm)
#pragma unroll
                    for (int bj = 0; bj < 2; ++bj) {
                        const int m = mh * 2 + mm;
                        const size_t off = (size_t)(row0 + ai * 128 + m * 16) * DM + col0 + bj * 128;
                        const u32x4 g4 = gw[mm][bj];
                        const f32x4 v0 = acc[ai][bj][m][0], v1 = acc[ai][bj][m][1];
                        f32x4 r0, r1;
                        r0[0] = fast_sigmoid(bf_lo(g4.x)) * v0[0]; r0[1] = fast_sigmoid(bf_hi(g4.x)) * v0[1]; r0[2] = fast_sigmoid(bf_lo(g4.y)) * v0[2]; r0[3] = fast_sigmoid(bf_hi(g4.y)) * v0[3];
                        r1[0] = fast_sigmoid(bf_lo(g4.z)) * v1[0]; r1[1] = fast_sigmoid(bf_hi(g4.z)) * v1[1]; r1[2] = fast_sigmoid(bf_lo(g4.w)) * v1[2]; r1[3] = fast_sigmoid(bf_hi(g4.w)) * v1[3];
                        if (PASS == 1) { *(f32x4*)(stash + off) = r0; *(f32x4*)(stash + off + 4) = r1; }
                        else {
                            r0 += st0[mm][bj]; r1 += st1[mm][bj];
                            u32x4 w; w.x = cvt_pk_bf16(r0[0], r0[1]); w.y = cvt_pk_bf16(r0[2], r0[3]); w.z = cvt_pk_bf16(r1[0], r1[1]); w.w = cvt_pk_bf16(r1[2], r1[3]);
                            *(u32x4*)(gate + off) = w;
                        }
                    }
                asm volatile("" ::: "memory");
            }
    }
};
struct EpiFFT1 {
    static constexpr int BMODE = 2;
    bf16_t* yt;
    __device__ __forceinline__ void operator()(const AccT& acc, const Unit& u, int wr, int wc, int fr, int fq) const {
        const int b = u.pn >> 4, n2 = (u.pn & 15) * 64 + 16 * wc + 4 * fq;
        float tc[3][4], ts[3][4];
#pragma unroll
        for (int k1 = 1; k1 < 4; ++k1)
#pragma unroll
            for (int j = 0; j < 4; ++j) { const float x = (float)(k1 * (n2 + j)) * (1.0f / 4096.0f); tc[k1 - 1][j] = __builtin_amdgcn_cosf(x); ts[k1 - 1][j] = __builtin_amdgcn_sinf(x); }
#pragma unroll
        for (int m = 0; m < 4; ++m) {
            const int col = u.pm * 128 + wr * 64 + m * 16 + fr;
            bf16_t* base = yt + ((size_t)(b * 4) * 512 + col) * 2048 + n2;
            float yr[4][4], yi[4][4];
#pragma unroll
            for (int j = 0; j < 4; ++j) {
                const float z0r = acc[0][0][m][0][j], z1r = acc[0][0][m][1][j], z2r = acc[0][1][m][0][j], z3r = acc[0][1][m][1][j];
                const float z0i = -acc[1][0][m][0][j], z1i = -acc[1][0][m][1][j], z2i = -acc[1][1][m][0][j], z3i = -acc[1][1][m][1][j];
                const float ar = z0r + z2r, ai_ = z0i + z2i, br = z1r + z3r, bi = z1i + z3i, cr = z0r - z2r, ci = z0i - z2i, dr = z1r - z3r, di = z1i - z3i;
                yr[0][j] = ar + br; yi[0][j] = ai_ + bi;
                yr[2][j] = ar - br; yi[2][j] = ai_ - bi;
                yr[1][j] = cr + di; yi[1][j] = ci - dr;
                yr[3][j] = cr - di; yi[3][j] = ci + dr;
            }
#pragma unroll
            for (int k1 = 0; k1 < 4; ++k1) {
                float orr[4], oi[4];
#pragma unroll
                for (int j = 0; j < 4; ++j) {
                    if (k1 == 0) { orr[j] = yr[0][j]; oi[j] = yi[0][j]; }
                    else { const float c = tc[k1 - 1][j], s_ = ts[k1 - 1][j]; orr[j] = c * yr[k1][j] + s_ * yi[k1][j]; oi[j] = c * yi[k1][j] - s_ * yr[k1][j]; }
                }
                u32x2 w; w.x = cvt_pk_bf16(orr[0], orr[1]); w.y = cvt_pk_bf16(orr[2], orr[3]);
                *(u32x2*)(base + (size_t)k1 * 512 * 2048) = w;
                w.x = cvt_pk_bf16(oi[0], oi[1]); w.y = cvt_pk_bf16(oi[2], oi[3]);
                *(u32x2*)(base + (size_t)k1 * 512 * 2048 + 1024) = w;
            }
        }
    }
};
struct EpiFFT2 {
    static constexpr int BMODE = 1;
    bf16_t* out;
    __device__ __forceinline__ void operator()(const AccT& acc, const Unit& u, int wr, int wc, int fr, int fq) const {
        const float scale = 0.001381067932004975f;
        const int b = u.pm >> 4, k1 = (u.pm >> 2) & 3, k2b = (u.pm & 3) * 256 + wr * 64 + fr, col0 = u.pn * 256 + wc * 32 + 8 * fq;
#pragma unroll
        for (int ai = 0; ai < 2; ++ai)
#pragma unroll
            for (int m = 0; m < 4; ++m) {
                const int k2 = k2b + ai * 128 + m * 16;
                bf16_t* rowp = out + (size_t)(b * 4096 + k1 + 4 * k2) * 512 + col0;
#pragma unroll
                for (int bj = 0; bj < 2; ++bj) {
                    const f32x4 v0 = acc[ai][bj][m][0] * scale, v1 = acc[ai][bj][m][1] * scale;
                    u32x4 w; w.x = cvt_pk_bf16(v0[0], v0[1]); w.y = cvt_pk_bf16(v0[2], v0[3]); w.z = cvt_pk_bf16(v1[0], v1[1]); w.w = cvt_pk_bf16(v1[2], v1[3]);
                    *(u32x4*)(rowp + bj * 128) = w;
                }
            }
    }
};

struct EpiPartial {
    static constexpr int BMODE = 1;
    float* out;
    __device__ __forceinline__ void operator()(const AccT& acc, const Unit& u, int wr, int wc, int fr, int fq) const {
        const int row0 = u.pm * 256 + wr * 64 + fr, col0 = u.pn * 256 + wc * 32 + 8 * fq;
#pragma unroll
        for (int ai = 0; ai < 2; ++ai)
#pragma unroll
            for (int m = 0; m < 4; ++m) {
                float* rowp = out + (size_t)(row0 + ai * 128 + m * 16) * DM + col0;
#pragma unroll
                for (int bj = 0; bj < 2; ++bj) { *(f32x4*)(rowp + bj * 128) = acc[ai][bj][m][0]; *(f32x4*)(rowp + bj * 128 + 4) = acc[ai][bj][m][1]; }
                asm volatile("" ::: "memory");
            }
    }
};
struct Args { const float* in[19]; float* out; unsigned char* ws; int ph_lo, ph_hi; };

__device__ __forceinline__ void transpose_item(const float* W, int ldw, int k0, int n0, bf16_t* dst, int ldd, LAS float* scr, int lane) {
#pragma unroll 8
    for (int i = 0; i < 32; ++i) { const int kk = 2 * i + (lane >> 5); scr[kk * 33 + (lane & 31)] = W[(size_t)(k0 + kk) * ldw + n0 + (lane & 31)]; }
    LDS_WAIT(); asm volatile("" ::: "memory");
    const int c = lane & 7;
#pragma unroll
    for (int j = 0; j < 4; ++j) { const int n = (lane >> 3) + 8 * j; const LAS float* s = scr + (8 * c) * 33 + n;
        u32x4 o; o.x = cvt_pk_bf16(s[0 * 33], s[1 * 33]); o.y = cvt_pk_bf16(s[2 * 33], s[3 * 33]); o.z = cvt_pk_bf16(s[4 * 33], s[5 * 33]); o.w = cvt_pk_bf16(s[6 * 33], s[7 * 33]);
        *(u32x4*)(dst + (size_t)n * ldd + k0 + 8 * c) = o; }
    LDS_WAIT(); asm volatile("" ::: "memory");
}
__device__ __forceinline__ void fold_item(const float* w_in, bf16_t* wint, int item, LAS float* scr, const LAS float* tab, int lane) {
    const int g = item & 3, d0 = (item >> 2) * 8;
#pragma unroll
    for (int i = 0; i < 8; ++i) { const float* src = w_in + (size_t)(d0 + i) * 4096 + 1536 + g * 128; scr[lane * 8 + i] = src[lane]; scr[(lane + 64) * 8 + i] = src[lane + 64]; }
    LDS_WAIT(); asm volatile("" ::: "memory");
    float p0[8], p1[8], q0[8], q1[8];
#pragma unroll
    for (int i = 0; i < 8; ++i) { p0[i] = 0.f; p1[i] = 0.f; q0[i] = 0.f; q1[i] = 0.f; }
    for (int c = 0; c < 128; ++c) {
        const int idx = (lane * c) & 127; const float cv = tab[idx], sv = tab[128 + idx]; const float sg = (c & 1) ? -1.f : 1.f;
        const f32x4 wa = *(const LAS f32x4*)(scr + c * 8), wb = *(const LAS f32x4*)(scr + c * 8 + 4);
        const float w[8] = {wa[0], wa[1], wa[2], wa[3], wb[0], wb[1], wb[2], wb[3]};
#pragma unroll
        for (int i = 0; i < 8; ++i) { p0[i] += w[i] * cv; q0[i] += w[i] * sv; p1[i] += w[i] * (cv * sg); q1[i] += w[i] * (sv * sg); }
    }
    u32x4 o;
    o.x = cvt_pk_bf16(p0[0], p0[1]); o.y = cvt_pk_bf16(p0[2], p0[3]); o.z = cvt_pk_bf16(p0[4], p0[5]); o.w = cvt_pk_bf16(p0[6], p0[7]);
    *(u32x4*)(wint + (size_t)(256 + g * 256 + lane) * DM + d0) = o;
    o.x = cvt_pk_bf16(p1[0], p1[1]); o.y = cvt_pk_bf16(p1[2], p1[3]); o.z = cvt_pk_bf16(p1[4], p1[5]); o.w = cvt_pk_bf16(p1[6], p1[7]);
    *(u32x4*)(wint + (size_t)(256 + g * 256 + lane + 64) * DM + d0) = o;
    o.x = cvt_pk_bf16(q0[0], q0[1]); o.y = cvt_pk_bf16(q0[2], q0[3]); o.z = cvt_pk_bf16(q0[4], q0[5]); o.w = cvt_pk_bf16(q0[6], q0[7]);
    *(u32x4*)(wint + (size_t)(384 + g * 256 + lane) * DM + d0) = o;
    o.x = cvt_pk_bf16(q1[0], q1[1]); o.y = cvt_pk_bf16(q1[2], q1[3]); o.z = cvt_pk_bf16(q1[4], q1[5]); o.w = cvt_pk_bf16(q1[6], q1[7]);
    *(u32x4*)(wint + (size_t)(384 + g * 256 + lane + 64) * DM + d0) = o;
    LDS_WAIT(); asm volatile("" ::: "memory");
}

__device__ __forceinline__ void phase_prep(const Args& a, LAS unsigned char* lds, const int wv) {
    unsigned char* ws = a.ws;
    const int tid = TID_FRESH(wv), lane = tid & 63, wave = wv;
    const int G = gridDim.x;
    {
        LAS float* condS = (LAS float*)(lds + 69632) + (tid >> 8) * (17 * 128);
        const int half = tid >> 8, t = tid & 255;
        const float* cvec = a.in[1]; const float* cctx = a.in[3]; const float* wada = a.in[4];
        float* modp = (float*)(ws + WS_MODP);
        for (int base = blockIdx.x * 2; base < 288; base += 2 * G) {
            const int it = base + half, s = it / 36, cb = it % 36;
            for (int i = t; i < 17 * 128; i += 256) { const int r = i >> 7, kk = i & 127; const float v = (r < 16) ? cvec[r * DM + s * 128 + kk] : cctx[s * 128 + kk]; condS[i] = v / (1.0f + __expf(-v)); }
            __syncthreads();
            float acc[17];
#pragma unroll
            for (int r = 0; r < 17; ++r) acc[r] = 0.f;
            const int col = cb * 256 + t;
            for (int kk = 0; kk < 128; ++kk) {
                const float w = wada[(size_t)(s * 128 + kk) * MODW + col];
#pragma unroll
                for (int r = 0; r < 17; ++r) acc[r] += condS[r * 128 + kk] * w;
            }
#pragma unroll
            for (int r = 0; r < 17; ++r) modp[(size_t)(s * 17 + r) * MODW + col] = acc[r];
            __syncthreads();
        }
    }
    LAS float* tab = (LAS float*)(lds + 69632 + 17408);
    if (tid < 128) { tab[tid] = cospif((float)tid * (1.0f / 64.0f)); tab[128 + tid] = sinpif((float)tid * (1.0f / 64.0f)); }
    __syncthreads();
    {
        float* rope = (float*)(ws + WS_ROPE);
        const int gt = blockIdx.x * 512 + tid;
        if (gt < 1024) { const int pos = gt >> 4, i = gt & 15; const float inv = powf(10000.0f, -(float)i * (1.0f / 16.0f)); const float ang = (float)pos * inv; rope[gt] = cosf(ang); rope[1024 + gt] = sinf(ang); }
    }
    {
        LAS float* scr = (LAS float*)(lds + wave * 8448);
        const int gw = blockIdx.x * 8 + wave, NGW = G * 8;
        bf16_t* w1in = (bf16_t*)(ws + WS_W1IN); bf16_t* w1out = (bf16_t*)(ws + WS_W1OUT); bf16_t* w2in = (bf16_t*)(ws + WS_W2IN); bf16_t* w2out = (bf16_t*)(ws + WS_W2OUT);
        bf16_t* winm = (bf16_t*)(ws + WS_WINM); bf16_t* wint = (bf16_t*)(ws + WS_WINT); bf16_t* wa = (bf16_t*)(ws + WS_WA); bf16_t* wf = (bf16_t*)(ws + WS_WF); bf16_t* wo = (bf16_t*)(ws + WS_WO);
#define TJOB(SRC, LDW, KK, NBEG, NCNT, DST, LDD, SWI) { const int nb_ = (NCNT) / 32, cnt_ = ((KK) / 64) * nb_; if (r < cnt_) { const int kb = r / nb_, nb = r % nb_; const int n0 = 32 * nb; int drow = n0; \
            if (SWI) { drow = (n0 < DFF) ? (256 * (n0 / 128) + (n0 % 128)) : (256 * ((n0 - DFF) / 128) + 128 + ((n0 - DFF) % 128)); } \
            transpose_item(SRC, LDW, 64 * kb, (NBEG) + n0, (DST) + (size_t)drow * (LDD), LDD, scr, lane); continue; } r -= cnt_; }
        constexpr int NIT = 2 * (16 * 176 + 44 * 32) + 16 * (40 + 8 + 64) + 16 * 32 + 8 * 32 + 16 * 32 + 512;
        for (int it = gw; it < NIT; it += NGW) {
            int r = it;
            TJOB(a.in[7], 2 * DFF, 1024, 0, 2 * DFF, w1in, 1024, 1)
            TJOB(a.in[8], DM, DFF, 0, DM, w1out, DFF, 0)
            TJOB(a.in[16], 2 * DFF, 1024, 0, 2 * DFF, w2in, 1024, 1)
            TJOB(a.in[17], DM, DFF, 0, DM, w2out, DFF, 0)
            TJOB(a.in[10], 4096, 1024, 0, 1280, winm, 1024, 0)
            TJOB(a.in[10], 4096, 1024, 1280, 256, wint, 1024, 0)
            TJOB(a.in[10], 4096, 1024, 2048, 2048, winm + (size_t)1280 * 1024, 1024, 0)
            TJOB(a.in[12], DM, 1024, 0, DM, wa, 1024, 0)
            TJOB(a.in[13], DM, 512, 0, DM, wf, 512, 0)
            TJOB(a.in[14], DM, 1024, 0, DM, wo, 1024, 0)
            fold_item(a.in[10], wint, r, scr, tab, lane);
        }
#undef TJOB
    }
    {
        bf16_t* dft = (bf16_t*)(ws + WS_DFT);
        const int nthr = G * 512;
        for (int idx = blockIdx.x * 512 + tid; idx < 1024 * 256; idx += nthr) {
            const int k = idx >> 8, ch = idx & 255, n0 = (ch * 8) & 1023; const bool sn = ch >= 128;
            float v[8];
#pragma unroll
            for (int e = 0; e < 8; ++e) { const float x = (float)((k * (n0 + e)) & 1023) * (1.0f / 512.0f); v[e] = sn ? sinpif(x) : cospif(x); }
            u32x4 o; o.x = cvt_pk_bf16(v[0], v[1]); o.y = cvt_pk_bf16(v[2], v[3]); o.z = cvt_pk_bf16(v[4], v[5]); o.w = cvt_pk_bf16(v[6], v[7]);
            *(u32x4*)(dft + (size_t)idx * 8) = o;
        }
    }
}

template <int MODE>
__device__ __forceinline__ void norm_phase(const Args& a, const float* xlat, const float* xctx, int nrows, const float* gvec, int midx, bf16_t* hout, float* fout, const int wv, const float* part = nullptr) {
    const int tid = TID_FRESH(wv), lane = tid & 63, wave = wv;
    const int gw = blockIdx.x * 8 + wave, NGW = gridDim.x * 8;
    const float* modp = (const float*)(a.ws + WS_MODP); const float* mod = (const float*)(a.ws + WS_MOD); const float* bada = a.in[5];
    int curb = -1; f32x4 A[4], Bv[4];
    const int nlat = nrows < NLAT ? nrows : NLAT, nctx = nrows - nlat;
    const int rpw_l = (nlat + NGW - 1) / NGW, rpw_c = (nctx + NGW - 1) / NGW;
    const int l_lo = gw * rpw_l, l_hi = min(nlat, l_lo + rpw_l), c_lo = NLAT + gw * rpw_c, c_hi = min(nrows, c_lo + rpw_c);
    const int n_l = l_hi > l_lo ? l_hi - l_lo : 0, n_c = c_hi > c_lo ? c_hi - c_lo : 0;
    for (int it = 0; it < n_l + n_c; ++it) {
        const int row = it < n_l ? l_lo + it : c_lo + (it - n_l);
        const bool isctx = row >= NLAT; const int b = isctx ? 16 : (row >> 12);
        if (b != curb) {
            curb = b;
#pragma unroll
            for (int j = 0; j < 4; ++j) {
                const int c = 4 * lane + 256 * j; const f32x4 g4 = *(const f32x4*)(gvec + c);
                if (MODE == 2) { A[j] = g4; Bv[j] = (f32x4){0.f, 0.f, 0.f, 0.f}; }
                else {
                    f32x4 sh, sc;
                    if (MODE == 0) {
                        sh = *(const f32x4*)(bada + midx * DM + c); sc = *(const f32x4*)(bada + (midx + 1) * DM + c);
#pragma unroll
                        for (int s = 0; s < 8; ++s) { sh += *(const f32x4*)(modp + (size_t)(s * 17 + b) * MODW + midx * DM + c); sc += *(const f32x4*)(modp + (size_t)(s * 17 + b) * MODW + (midx + 1) * DM + c); }
                    } else { sh = *(const f32x4*)(mod + (size_t)b * MODW + midx * DM + c); sc = *(const f32x4*)(mod + (size_t)b * MODW + (midx + 1) * DM + c); }
                    A[j] = g4 * (sc + 1.0f); Bv[j] = sh;
                }
            }
        }
        const float* xr = isctx ? xctx + (size_t)(row - NLAT) * DM : xlat + (size_t)row * DM;
        f32x4 v[4]; float ss = 0.f;
#pragma unroll
        for (int j = 0; j < 4; ++j) {
            v[j] = *(const f32x4*)(xr + 4 * lane + 256 * j);
            if (MODE == 1 && part != nullptr && isctx) {
                const size_t po = (size_t)(row - NLAT) * DM + 4 * lane + 256 * j;
                const f32x4 ps = (*(const f32x4*)(part + po) + *(const f32x4*)(part + (size_t)NCTX * DM + po)) + (*(const f32x4*)(part + (size_t)2 * NCTX * DM + po) + *(const f32x4*)(part + (size_t)3 * NCTX * DM + po));
                v[j] += (*(const f32x4*)(mod + (size_t)16 * MODW + 2 * DM + 4 * lane + 256 * j) * 0.5f) * ps;
            }
            ss += (v[j][0] * v[j][0] + v[j][1] * v[j][1]) + (v[j][2] * v[j][2] + v[j][3] * v[j][3]);
        }
        const float rs = rsqrtf(wave_sum(ss) * (1.0f / DM) + RMS_EPS);
#pragma unroll
        for (int j = 0; j < 4; ++j) {
            const f32x4 o = (v[j] * rs) * A[j] + Bv[j];
            if (MODE == 2) *(f32x4*)(fout + (size_t)row * DM + 4 * lane + 256 * j) = o;
            else { u32x2 w; w.x = cvt_pk_bf16(o[0], o[1]); w.y = cvt_pk_bf16(o[2], o[3]); *(u32x2*)(hout + (size_t)row * DM + 4 * lane + 256 * j) = w; }
        }
    }
}

__device__ __forceinline__ void attn_phase(LAS unsigned char* lds, const bf16_t* q, const bf16_t* k, const bf16_t* vt, const bf16_t* kc, const bf16_t* vtc, const float* sink, bf16_t* aout, const int wv) {
    const int tid = TID_FRESH(wv), wid = wv, lane = tid & 63, g = lane >> 4, lq = lane & 15;
    const int hw = wid >> 2, r0 = (wid & 3) * 32;
    const int srow = tid >> 3, sch = tid & 7;
    const int wj0 = (r0 >= 64) ? 1 : 0;
    const unsigned soff = srow * 144 + sch * 16;
    constexpr int VOFF = 6 * 9216;
    u32x4 kreg[6], vreg[6];
#define ATT_LOAD_LOCAL(IT) do { const int hp_ = (IT) & 1, kvh_ = ((IT) >> 1) & 3, qb_ = ((IT) >> 3) & 31, b_ = (IT) >> 8; (void)hp_; \
        const int jl0_ = (qb_ == 0) ? 2 : 0, jl1_ = (qb_ == 31) ? 3 : 5; \
        const bf16_t* kbase_ = k + (size_t)(b_ * SEQ + srow) * 256 + kvh_ * 64 + sch * 8; \
        const bf16_t* vbase_ = vt + (size_t)(kvh_ * 64 + srow) * NLAT + (size_t)b_ * SEQ + sch * 8; \
        _Pragma("unroll") for (int t_ = 0; t_ < 6; ++t_) if (jl0_ + t_ <= jl1_) { const int kp0_ = qb_ * 128 - 128 + 64 * (jl0_ + t_); kreg[t_] = *(const u32x4*)(kbase_ + (size_t)kp0_ * 256); vreg[t_] = *(const u32x4*)(vbase_ + kp0_); } } while (0)
    if ((int)blockIdx.x < 4096) ATT_LOAD_LOCAL((int)blockIdx.x);
    for (int item = blockIdx.x; item < 4096; item += gridDim.x) {
        const int hp = item & 1, kvh = (item >> 1) & 3, qb = (item >> 3) & 31, b = item >> 8;
        const int h = kvh * 4 + hp * 2 + hw, start = qb * 128;
        const int jl0 = (qb == 0) ? 2 : 0, jl1 = (qb == 31) ? 3 : 5, nloc = jl1 - jl0 + 1;
        __syncthreads();
#pragma unroll
        for (int t = 0; t < 6; ++t) if (t < nloc) { *(LAS u32x4*)(lds + t * 9216 + soff) = kreg[t]; *(LAS u32x4*)(lds + VOFF + t * 9216 + soff) = vreg[t]; }
        bf16x8 qf[2][2];
#pragma unroll
        for (int qt = 0; qt < 2; ++qt)
#pragma unroll
            for (int ks = 0; ks < 2; ++ks) qf[qt][ks] = *(const bf16x8*)(q + (size_t)(b * SEQ + start + r0 + 16 * qt + lq) * 1024 + h * 64 + 32 * ks + 8 * g);
        const float sk = sink[h] * LOG2E;
        float mrun[2] = {sk, sk}, lrun[2] = {g == 0 ? 1.f : 0.f, g == 0 ? 1.f : 0.f};
        f32x4 o[4][2];
#pragma unroll
        for (int dt = 0; dt < 4; ++dt)
#pragma unroll
            for (int qt = 0; qt < 2; ++qt) o[dt][qt] = (f32x4){0.f, 0.f, 0.f, 0.f};
        __syncthreads();
        {
            const bf16_t* kcbase = kc + (size_t)(b * CTXL + srow) * 256 + kvh * 64 + sch * 8;
            const bf16_t* vcbase = vtc + (size_t)(kvh * 64 + srow) * NCTX + b * CTXL + sch * 8;
#pragma unroll
            for (int t = 0; t < 4; ++t) { kreg[t] = *(const u32x4*)(kcbase + (size_t)(64 * t) * 256); vreg[t] = *(const u32x4*)(vcbase + 64 * t); }
        }
        auto tile = [&](const int slot, const bool domask, const int jrel) {
            const LAS unsigned char* kb = lds + slot * 9216; const LAS unsigned char* vb = lds + VOFF + slot * 9216;
            f32x4 s[4][2];
#pragma unroll
            for (int kt = 0; kt < 4; ++kt) {
                const bf16x8 k0 = *(const LAS bf16x8*)(kb + (16 * kt + lq) * 144 + (8 * g) * 2), k1 = *(const LAS bf16x8*)(kb + (16 * kt + lq) * 144 + (32 + 8 * g) * 2);
#pragma unroll
                for (int qt = 0; qt < 2; ++qt) {
                    f32x4 z = (f32x4){0.f, 0.f, 0.f, 0.f};
                    z = __builtin_amdgcn_mfma_f32_16x16x32_bf16(k0, qf[qt][0], z, 0, 0, 0);
                    s[kt][qt] = __builtin_amdgcn_mfma_f32_16x16x32_bf16(k1, qf[qt][1], z, 0, 0, 0);
                }
            }
            if (domask) {
                const int kp0 = -128 + 64 * jrel + 4 * g;
#pragma unroll
                for (int kt = 0; kt < 4; ++kt)
#pragma unroll
                    for (int qt = 0; qt < 2; ++qt)
#pragma unroll
                        for (int r = 0; r < 4; ++r) { const int d = (kp0 + 16 * kt + r) - (r0 + 16 * qt + lq); if (d > 128 || d < -128) s[kt][qt][r] = -1e30f; }
            }
            bf16x8 pb[2][2];
#pragma unroll
            for (int qt = 0; qt < 2; ++qt) {
                float mx = -3e38f;
#pragma unroll
                for (int kt = 0; kt < 4; ++kt) mx = fmaxf(mx, fmaxf(fmaxf(s[kt][qt][0], s[kt][qt][1]), fmaxf(s[kt][qt][2], s[kt][qt][3])));
                mx = fmaxf(mx, __shfl_xor(mx, 16)); mx = fmaxf(mx, __shfl_xor(mx, 32));
                const float mn = fmaxf(mrun[qt], mx), alpha = __builtin_amdgcn_exp2f(mrun[qt] - mn);
                mrun[qt] = mn;
                float ls = 0.f;
#pragma unroll
                for (int kt = 0; kt < 4; ++kt)
#pragma unroll
                    for (int r = 0; r < 4; ++r) { const float p = __builtin_amdgcn_exp2f(s[kt][qt][r] - mn); s[kt][qt][r] = p; ls += p; }
                lrun[qt] = lrun[qt] * alpha + ls;
#pragma unroll
                for (int dt = 0; dt < 4; ++dt) o[dt][qt] *= alpha;
#pragma unroll
                for (int kp = 0; kp < 2; ++kp) {
                    u32x4 w; w.x = cvt_pk_bf16(s[2 * kp][qt][0], s[2 * kp][qt][1]); w.y = cvt_pk_bf16(s[2 * kp][qt][2], s[2 * kp][qt][3]);
                    w.z = cvt_pk_bf16(s[2 * kp + 1][qt][0], s[2 * kp + 1][qt][1]); w.w = cvt_pk_bf16(s[2 * kp + 1][qt][2], s[2 * kp + 1][qt][3]);
                    pb[qt][kp] = __builtin_bit_cast(bf16x8, w);
                }
            }
#pragma unroll
            for (int dt = 0; dt < 4; ++dt)
#pragma unroll
                for (int kp = 0; kp < 2; ++kp) {
                    const u32x2 va = *(const LAS u32x2*)(vb + (16 * dt + lq) * 144 + (32 * kp + 4 * g) * 2), vc = *(const LAS u32x2*)(vb + (16 * dt + lq) * 144 + (32 * kp + 16 + 4 * g) * 2);
                    u32x4 vw; vw.x = va.x; vw.y = va.y; vw.z = vc.x; vw.w = vc.y;
                    const bf16x8 vf = __builtin_bit_cast(bf16x8, vw);
#pragma unroll
                    for (int qt = 0; qt < 2; ++qt) o[dt][qt] = __builtin_amdgcn_mfma_f32_16x16x32_bf16(vf, pb[qt][kp], o[dt][qt], 0, 0, 0);
                }
        };
        for (int t = 0; t < nloc; ++t) { const int j = jl0 + t; if (j >= wj0 && j <= wj0 + 4) tile(t, j == wj0 || j == wj0 + 4, j); }
        __syncthreads();
#pragma unroll
        for (int t = 0; t < 4; ++t) { *(LAS u32x4*)(lds + t * 9216 + soff) = kreg[t]; *(LAS u32x4*)(lds + VOFF + t * 9216 + soff) = vreg[t]; }
        __syncthreads();
        if (item + (int)gridDim.x < 4096) ATT_LOAD_LOCAL(item + (int)gridDim.x);
        for (int t = 0; t < 4; ++t) tile(t, false, 0);
#pragma unroll
        for (int qt = 0; qt < 2; ++qt) {
            float lt = lrun[qt]; lt += __shfl_xor(lt, 16); lt += __shfl_xor(lt, 32);
            const float inv = 1.0f / lt;
            bf16_t* orow = aout + (size_t)(b * SEQ + start + r0 + 16 * qt + lq) * 1024 + h * 64 + 4 * g;
#pragma unroll
            for (int dt = 0; dt < 4; ++dt) { const f32x4 ov = o[dt][qt] * inv; u32x2 w; w.x = cvt_pk_bf16(ov[0], ov[1]); w.y = cvt_pk_bf16(ov[2], ov[3]); *(u32x2*)(orow + 16 * dt) = w; }
        }
    }
#undef ATT_LOAD_LOCAL
}

#define XB_TMO      128
#define XB_XCNT(j)  (256  + 64 * (j))
#define XB_XSUB(j)  (1280 + 64 * (j))
#define XB_XGEN(j)  (2304 + 64 * (j))
#define XB_TOP      3328
#define XB_TOPGEN   3392
#define XCD_BAR_WORDS 3456
#define XB_SPIN_CAP (1u << 18)
__device__ __forceinline__ unsigned xb_ld(unsigned* p)              { return __hip_atomic_load(p, __ATOMIC_RELAXED, __HIP_MEMORY_SCOPE_AGENT); }
__device__ __forceinline__ unsigned xb_add(unsigned* p, unsigned v) { return __hip_atomic_fetch_add(p, v, __ATOMIC_RELAXED, __HIP_MEMORY_SCOPE_AGENT); }
__device__ __forceinline__ unsigned xb_xcc_id() { return (unsigned)__builtin_amdgcn_s_getreg((3 << 11) | 20) & 0xFu; }
#define XB_SPIN(cond, bar) do { unsigned _sp = 0; while (cond) { __builtin_amdgcn_s_sleep(1); \
    if ((++_sp & 255u) == 0u) { if (xb_ld(&(bar)[XB_TMO])) break; if (_sp > XB_SPIN_CAP) { atomicAdd(&(bar)[XB_TMO], 1u); break; } } } } while (0)
struct XcdBarrier { unsigned* bar; unsigned x; volatile LAS unsigned* st; };
__device__ __forceinline__ XcdBarrier xcd_barrier_post(unsigned* bar, volatile LAS unsigned* st, const int wv) {
    XcdBarrier b; b.bar = bar; b.x = xb_xcc_id(); b.st = st;
    if (TID_FRESH(wv) == 0) (void)xb_add(&bar[XB_XCNT(b.x)], 1u);
    return b;
}
__device__ __forceinline__ void xcd_barrier_complete(unsigned* bar, unsigned x, unsigned& nloc, unsigned& nx) {
    const unsigned G = gridDim.x * gridDim.y * gridDim.z;
    unsigned sum, cnt, mine, sp = 0u;
    for (;;) {
        sum = 0u; cnt = 0u; mine = 0u;
#pragma unroll
        for (unsigned j = 0; j < 16; ++j) { const unsigned c = xb_ld(&bar[XB_XCNT(j)]); sum += c; cnt += (c > 0u) ? 1u : 0u; mine = (j == x) ? c : mine; }
        if (sum == G) break;
        __builtin_amdgcn_s_sleep(1);
        if ((++sp & 255u) == 0u) { if (xb_ld(&bar[XB_TMO])) break; if (sp > XB_SPIN_CAP) { atomicAdd(&bar[XB_TMO], 1u); break; } }
    }
    nloc = mine > 0u ? mine : 1u; nx = cnt > 0u ? cnt : 1u;
}
__device__ __forceinline__ void xcd_barrier(const XcdBarrier& b, const int wv) {
    asm volatile("s_waitcnt vmcnt(0)" ::: "memory");
    __syncthreads();
    if (TID_FRESH(wv) == 0) {
        unsigned* bar = b.bar;
        __builtin_amdgcn_s_waitcnt(0);
        unsigned nloc = b.st[0], nx = b.st[1];
        if (nloc == 0u) { xcd_barrier_complete(bar, b.x, nloc, nx); b.st[0] = nloc; b.st[1] = nx; }
        const unsigned old = xb_add(&bar[XB_XSUB(b.x)], 1u);
        const unsigned gen = old / nloc;
        if (old + 1u == (gen + 1u) * nloc) {
            __builtin_amdgcn_fence(__ATOMIC_RELEASE, "agent");
            asm volatile("s_waitcnt vmcnt(0)" ::: "memory");
            const unsigned og = xb_add(&bar[XB_TOP], 1u);
            const unsigned tg = og / nx;
            if (og + 1u == (tg + 1u) * nx) xb_add(&bar[XB_TOPGEN], 1u);
            else XB_SPIN(xb_ld(&bar[XB_TOPGEN]) == tg, bar);
            __builtin_amdgcn_fence(__ATOMIC_ACQUIRE, "agent");
            xb_add(&bar[XB_XGEN(b.x)], 1u);
            asm volatile("s_waitcnt vmcnt(0)" ::: "memory");
        } else {
            XB_SPIN(xb_ld(&bar[XB_XGEN(b.x)]) == gen, bar);
            __builtin_amdgcn_fence(__ATOMIC_ACQUIRE, "agent");
            asm volatile("s_waitcnt vmcnt(0)" ::: "memory");
        }
    }
    __syncthreads();
}

constexpr int NPHASE = 13;
__global__ void __launch_bounds__(512) fwd_megakernel(Args a) {
    extern __shared__ __attribute__((aligned(16))) unsigned char lds_raw[];
    LAS unsigned char* lds = (LAS unsigned char*)lds_raw;
    cg::grid_group grid = cg::this_grid();
    const int wv = __builtin_amdgcn_readfirstlane((int)threadIdx.x >> 6);
    volatile LAS unsigned* xst = (volatile LAS unsigned*)(lds + 131072);
    if (TID_FRESH(wv) == 0) { xst[0] = 0u; xst[1] = 0u; }
    __syncthreads();
    XcdBarrier xbar; xbar.bar = (unsigned*)(a.ws + WS_BAR); xbar.x = 0; xbar.st = xst;
    if (a.ph_hi - a.ph_lo > 1) xbar = xcd_barrier_post((unsigned*)(a.ws + WS_BAR), xst, wv);
#define DEF_PTRS \
    unsigned char* ws = a.ws; float* outp = a.out; asm volatile("" : "+s"(ws), "+s"(outp)); \
    const bf16_t* w1in = (const bf16_t*)(ws + WS_W1IN); const bf16_t* w1out = (const bf16_t*)(ws + WS_W1OUT); const bf16_t* w2in = (const bf16_t*)(ws + WS_W2IN); const bf16_t* w2out = (const bf16_t*)(ws + WS_W2OUT); \
    const bf16_t* winm = (const bf16_t*)(ws + WS_WINM); const bf16_t* wint = (const bf16_t*)(ws + WS_WINT); const bf16_t* wa = (const bf16_t*)(ws + WS_WA); const bf16_t* wf = (const bf16_t*)(ws + WS_WF); const bf16_t* wo = (const bf16_t*)(ws + WS_WO); \
    const bf16_t* dft = (const bf16_t*)(ws + WS_DFT); \
    float* mod = (float*)(ws + WS_MOD); const float* rope = (const float*)(ws + WS_ROPE); \
    bf16_t* hbuf = (bf16_t*)(ws + WS_H); bf16_t* act = (bf16_t*)(ws + WS_ACT); float* X = (float*)(ws + WS_X); \
    bf16_t* qb_ = (bf16_t*)(ws + WS_ACT + AO_Q); bf16_t* kb_ = (bf16_t*)(ws + WS_ACT + AO_K); bf16_t* vtb = (bf16_t*)(ws + WS_ACT + AO_VT); bf16_t* pqt = (bf16_t*)(ws + WS_ACT + AO_PQT); \
    bf16_t* fb = (bf16_t*)(ws + WS_F); bf16_t* kcb = (bf16_t*)(ws + WS_ACT + AO_KC); bf16_t* vtcb = (bf16_t*)(ws + WS_ACT + AO_VTC); \
    float* stash = (float*)(ws + WS_ACT); \
    bf16_t* gab = (bf16_t*)outp; bf16_t* gfb = gab + (size_t)NLAT * DM; \
    bf16_t* ab = hbuf; \
    (void)w1in; (void)w1out; (void)w2in; (void)w2out; (void)winm; (void)wint; (void)wa; (void)wf; (void)wo; (void)dft; (void)mod; (void)rope; (void)hbuf; (void)act; (void)X; (void)qb_; (void)kb_; (void)vtb; (void)pqt; (void)fb; (void)kcb; (void)vtcb; (void)stash; (void)gab; (void)gfb; (void)ab;
#define RUN(N) (a.ph_lo <= (N) && (N) < a.ph_hi)
#define SYNC_AFTER(N) if (a.ph_lo <= (N) && (N) + 1 < a.ph_hi) { if (a.ph_hi > NPHASE) grid.sync(); else xcd_barrier(xbar, wv); }
#define STEP_BEGIN { DEF_PTRS
#define STEP_END }

    if (RUN(0)) { phase_prep(a, lds, wv); }
    SYNC_AFTER(0)
    if (RUN(1)) STEP_BEGIN
        const float* modp = (const float*)(ws + WS_MODP); const float* bada = a.in[5];
        for (int i = blockIdx.x * 512 + TID_FRESH(wv); i < 17 * MODW; i += gridDim.x * 512) { float s = bada[i % MODW];
#pragma unroll
            for (int sp = 0; sp < 8; ++sp) s += modp[(size_t)sp * 17 * MODW + i]; mod[i] = s; }
        norm_phase<0>(a, a.in[0], a.in[2], NTOK, a.in[6], 0, hbuf, nullptr, wv);
    STEP_END
    SYNC_AFTER(1)
    if (RUN(2)) STEP_BEGIN Gemm g{hbuf, w1in, DM, DM, DM, NTOK / 256, 22, 1 << 30, 0, 0, 0}; EpiSwiglu e{act}; gemm_phase(lds, g, e, wv); STEP_END
    SYNC_AFTER(2)
    if (RUN(3)) {
        STEP_BEGIN Gemm g{act, w1out, DFF, DFF, DFF, 256, 4, 1 << 30, 0, 0, 0}; EpiResid e{a.in[0], a.in[2], X, mod, 2, 0.5f}; gemm_phase(lds, g, e, wv); STEP_END
        STEP_BEGIN Gemm g{act + (size_t)NLAT * DFF, w1out, DFF, DFF, 768, 48, 4, 16, 768, 768, 0}; EpiPartial e{(float*)(ws + WS_PART)}; gemm_phase(lds, g, e, wv); STEP_END
        STEP_BEGIN Gemm g{act + (size_t)NLAT * DFF + 2304, w1out + 2304, DFF, DFF, 512, 16, 4, 1 << 30, 0, 0, 64}; EpiPartial e{(float*)(ws + WS_PART) + (size_t)3 * NCTX * DM}; gemm_phase(lds, g, e, wv); STEP_END
    }
    SYNC_AFTER(3)
    if (RUN(4)) STEP_BEGIN norm_phase<1>(a, X, a.in[2], NTOK, a.in[9], 3, hbuf, nullptr, wv, (const float*)(ws + WS_PART)); STEP_END
    SYNC_AFTER(4)
    if (RUN(5)) {
        STEP_BEGIN Gemm g{hbuf, winm, DM, DM, DM, 256, 13, 1 << 30, 0, 0, 0}; EpiQKG e{qb_, kb_, gab, gfb, rope}; gemm_phase(lds, g, e, wv); STEP_END
        STEP_BEGIN Gemm g{wint + (size_t)256 * DM, hbuf, DM, DM, DM, 4, 256, 1 << 30, 0, 0, 0}; EpiFFT1 e{pqt}; gemm_phase(lds, g, e, wv); STEP_END
        STEP_BEGIN Gemm g{wint, hbuf, DM, DM, DM, 1, 256, 1 << 30, 0, 0, 0}; EpiT<true> e{vtb, NLAT, vtb}; gemm_phase(lds, g, e, wv); STEP_END
        STEP_BEGIN Gemm g{hbuf + (size_t)NLAT * DM, winm + (size_t)1024 * DM, DM, DM, DM, 16, 1, 1 << 30, 0, 0, 0}; EpiPlain e{kcb, 256, 1.0f}; gemm_phase(lds, g, e, wv); STEP_END
        STEP_BEGIN Gemm g{wint, hbuf + (size_t)NLAT * DM, DM, DM, DM, 1, 16, 1 << 30, 0, 0, 128}; EpiT<true> e{vtcb, NCTX, vtcb}; gemm_phase(lds, g, e, wv); STEP_END
    }
    SYNC_AFTER(5)
    if (RUN(6)) {
        STEP_BEGIN attn_phase(lds, qb_, kb_, vtb, kcb, vtcb, a.in[11], ab, wv); STEP_END
        __syncthreads();
        STEP_BEGIN Gemm g{dft, pqt, 2048, 2048, 2048, 256, 2, 4, (size_t)512 * 2048, 0, 0}; EpiFFT2 e{fb}; gemm_phase(lds, g, e, wv); STEP_END
    }
    SYNC_AFTER(6)
    if (RUN(7)) {
        STEP_BEGIN Gemm g{ab, wa, DM, DM, DM, 256, 4, 1 << 30, 0, 0, 0}; EpiMerge<1> e{stash, gab}; gemm_phase(lds, g, e, wv); STEP_END
        STEP_BEGIN Gemm g{fb, wf, 512, 512, 512, 256, 4, 1 << 30, 0, 0, 0}; EpiMerge<2> e{stash, gfb}; gemm_phase(lds, g, e, wv); STEP_END
    }
    SYNC_AFTER(7)
    if (RUN(8)) STEP_BEGIN Gemm g{gfb, wo, DM, DM, DM, 256, 4, 1 << 30, 0, 0, 0}; EpiResid e{X, X, X, mod, 5, 1.0f}; gemm_phase(lds, g, e, wv); STEP_END
    SYNC_AFTER(8)
    if (RUN(9)) STEP_BEGIN norm_phase<1>(a, X, X, NLAT, a.in[15], 6, hbuf, nullptr, wv); STEP_END
    SYNC_AFTER(9)
    if (RUN(10)) STEP_BEGIN Gemm g{hbuf, w2in, DM, DM, DM, 256, 22, 1 << 30, 0, 0, 0}; EpiSwiglu e{act}; gemm_phase(lds, g, e, wv); STEP_END
    SYNC_AFTER(10)
    if (RUN(11)) STEP_BEGIN Gemm g{act, w2out, DFF, DFF, DFF, 256, 4, 1 << 30, 0, 0, 0}; EpiResid e{X, X, outp, mod, 8, 0.5f}; gemm_phase(lds, g, e, wv); STEP_END
    SYNC_AFTER(11)
    if (RUN(12)) STEP_BEGIN norm_phase<2>(a, outp, outp, NLAT, a.in[18], 0, nullptr, outp, wv); STEP_END
}

extern "C" void kernel_launch(void* const* d_in, const int* in_sizes, int n_in, void* d_out, int out_size, void* d_ws, size_t ws_size, hipStream_t stream) {
    static int grid_blocks = 0;
    if (grid_blocks == 0) {
        if (n_in != 19 || out_size != NLAT * DM || ws_size < WS_END) { fprintf(stderr, "kernel_launch: unexpected shapes (n_in %d out %d ws %zu need %zu)\n", n_in, out_size, ws_size, (size_t)WS_END); grid_blocks = -1; return; }
        int dev = 0, cus = 0, per_cu = 0;
        (void)hipGetDevice(&dev);
        (void)hipDeviceGetAttribute(&cus, hipDeviceAttributeMultiprocessorCount, dev);
        if (hipFuncSetAttribute((const void*)fwd_megakernel, hipFuncAttributeMaxDynamicSharedMemorySize, LDS_BYTES) != hipSuccess) { fprintf(stderr, "kernel_launch: hipFuncSetAttribute failed\n"); grid_blocks = -1; return; }
        if (hipOccupancyMaxActiveBlocksPerMultiprocessor(&per_cu, (const void*)fwd_megakernel, 512, LDS_BYTES) != hipSuccess || per_cu < 1) { fprintf(stderr, "kernel_launch: occupancy query says %d blocks per CU\n", per_cu); per_cu = 1; (void)hipGetLastError(); }
        grid_blocks = cus;
        (void)per_cu;
    }
    if (grid_blocks < 0) return;
    Args a{};
    for (int i = 0; i < 19; ++i) a.in[i] = (const float*)d_in[i];
    a.out = (float*)d_out; a.ws = (unsigned char*)d_ws;
#if N_LAUNCH_PER_PHASE
    for (int ph = 0; ph < NPHASE; ++ph) {
        a.ph_lo = ph; a.ph_hi = ph + 1;
        hipLaunchKernelGGL(fwd_megakernel, dim3(grid_blocks), dim3(512), LDS_BYTES, stream, a);
    }
#else
    a.ph_lo = 0; a.ph_hi = NPHASE;
    if (hipMemsetAsync((char*)d_ws + WS_BAR, 0, 16384, stream) != hipSuccess) { fprintf(stderr, "kernel_launch: memset of the barrier words failed\n"); return; }
    void* args[] = {&a};
    hipError_t e = hipLaunchCooperativeKernel((const void*)fwd_megakernel, dim3(grid_blocks), dim3(512), args, LDS_BYTES, stream);
    if (e != hipSuccess) fprintf(stderr, "kernel_launch: cooperative launch failed: %s (grid %d)\n", hipGetErrorString(e), grid_blocks);
#endif
}
```
